# Optimizing an MI355X kernel written in HIP

```python
import jax, jax.numpy as jnp
from jax import lax
import numpy as np

D_MODEL = 2048
BATCH = 32
SEQ = 256
DEPTH = 2
DEC_BATCH = 4
DEC_SEQ = 2048
PAST_LEN = 256

GRID_W = 64
N_DIR = 2
EPS = 1e-6
ROPE_BASE = 10000.0
GLA_HEADS = 6
GLA_DK = 64
GLA_DV = 128
GLA_WIDTH = GLA_HEADS * GLA_DV
GLA_QK_WIDTH = GLA_HEADS * GLA_DK
GLA_LORA = 16
GLA_CHUNK = 64
GLA_GATE_NORM = 16.0
GLA_LOG_DECAY_MIN = -1.0
CM_GROUPS = 4
CM_GROUP_DIM = 128
CM_WIDTH = CM_GROUPS * CM_GROUP_DIM
CM_CHUNK = 128
RW_HEADS = 12
RW_HEAD_DIM = 64
RW_WIDTH = RW_HEADS * RW_HEAD_DIM
RW_DECAY_LORA = 64
RW_ICLR_LORA = 64
RW_GN_EPS = 64e-5
MIX_WIDTH = GLA_WIDTH + CM_WIDTH + RW_WIDTH
SPLIT_SIZES = (GLA_QK_WIDTH, GLA_QK_WIDTH, GLA_WIDTH, GLA_WIDTH, GLA_LORA,
               CM_WIDTH, CM_WIDTH, CM_WIDTH,
               RW_WIDTH, RW_WIDTH, RW_WIDTH, RW_WIDTH, RW_DECAY_LORA, RW_ICLR_LORA)
IN_WIDTH = 7056

kernel_name = 'hybrid_gla_chunkmlp_rwkv7_dit_step'


def _rmsnorm(x, w):
    xf = x.astype(jnp.float32)
    y = xf * lax.rsqrt(jnp.mean(xf * xf, axis=-1, keepdims=True) + EPS)
    return (y * w.astype(jnp.float32)).astype(x.dtype)


def _modulation(cond, w_mod, b_mod):
    m = (jax.nn.silu(cond) @ w_mod + b_mod)[:, None, :]
    return jnp.split(m, 3, axis=-1)


def _split_cols(z):
    parts, off = [], 0
    for size in SPLIT_SIZES:
        parts.append(z[..., off:off + size])
        off += size
    return parts


def _rope_1d(x, pos):
    half = x.shape[-1] // 2
    inv = ROPE_BASE ** (-jnp.arange(half, dtype=jnp.float32) / half)
    ang = pos.astype(jnp.float32)[:, None] * inv[None, :]
    cos, sin = jnp.cos(ang)[:, None, :], jnp.sin(ang)[:, None, :]
    x1, x2 = x[..., :half], x[..., half:]
    return jnp.concatenate([x1 * cos - x2 * sin, x1 * sin + x2 * cos], axis=-1)


def _rope_grid(x):
    L = x.shape[1]
    rows = L // GRID_W
    row = jnp.repeat(jnp.arange(rows), GRID_W)
    col = jnp.tile(jnp.arange(GRID_W), rows)
    h = x.shape[-1] // 2
    return jnp.concatenate([_rope_1d(x[..., :h], row), _rope_1d(x[..., h:], col)], axis=-1)


def _gla_chunked(q, k, v, log_a, s0):
    B, L, H, dk = q.shape
    dv = v.shape[-1]
    C = GLA_CHUNK
    n = L // C
    q, k, v, log_a = [t.reshape(B, n, C, H, t.shape[-1]) for t in (q, k, v, log_a)]
    b = jnp.cumsum(log_a, axis=2)
    b_last = b[:, :, -1]
    q_t = q * jnp.exp(b)
    k_t = k * jnp.exp(-b)
    k_end = k * jnp.exp(b_last[:, :, None] - b)
    mask = jnp.tril(jnp.ones((C, C), dtype=bool))
    att = jnp.where(mask, jnp.einsum('bnihk,bnjhk->bnhij', q_t, k_t), 0.0)
    o_intra = jnp.einsum('bnhij,bnjhv->bnihv', att, v)
    kv = jnp.einsum('bnchk,bnchv->bnhkv', k_end, v)
    decay = jnp.exp(b_last)

    def step(s, inp):
        dec, kv_c = inp
        return dec[..., None] * s + kv_c, s

    s_final, s_prev = lax.scan(step, s0, (jnp.moveaxis(decay, 1, 0), jnp.moveaxis(kv, 1, 0)))
    s_prev = jnp.moveaxis(s_prev, 0, 1)
    o_inter = jnp.einsum('bnchk,bnhkv->bnchv', q_t, s_prev)
    return (o_intra + o_inter).reshape(B, L, H, dv), s_final


def _gla_branch(q, k, v, lora, lw, s0, latent):
    B, L, _ = q.shape
    f32 = jnp.float32
    q = q.astype(f32).reshape(B, L, GLA_HEADS, GLA_DK) * (GLA_DK ** -0.5)
    k = k.astype(f32).reshape(B, L, GLA_HEADS, GLA_DK)
    v = v.astype(f32).reshape(B, L, GLA_HEADS, GLA_DV)
    if latent:
        q, k = _rope_grid(q), _rope_grid(k)
    z = (jnp.einsum('blr,drk->dblk', lora.astype(f32), lw['gla_a2'].astype(f32))
         + lw['gla_a_bias'].astype(f32)[:, None, None, :])
    log_a = jnp.maximum(jax.nn.log_sigmoid(z) / GLA_GATE_NORM, GLA_LOG_DECAY_MIN)
    log_a = log_a.reshape(N_DIR, B, L, GLA_HEADS, GLA_DK)
    s0 = s0.astype(f32)
    flip = lambda t: jnp.flip(t, axis=1)
    o_f, s_f = _gla_chunked(q, k, v, log_a[0], s0[:, 0])
    o_b, s_b = _gla_chunked(flip(q), flip(k), flip(v), flip(log_a[1]), s0[:, 1])
    o = o_f + flip(o_b)
    o = (o * lax.rsqrt(jnp.mean(o * o, axis=-1, keepdims=True) + EPS)
         * lw['gla_norm_w'].astype(f32).reshape(GLA_HEADS, GLA_DV))
    return o.reshape(B, L, GLA_WIDTH), jnp.stack([s_f, s_b], axis=1)


def _chunk_mlp_branch(u, v, lw):
    B, L, _ = u.shape
    f32 = jnp.float32
    n = L // CM_CHUNK
    v = v.astype(f32).reshape(B, L, CM_GROUPS, CM_GROUP_DIM)
    v = (v * lax.rsqrt(jnp.mean(v * v, axis=-1, keepdims=True) + EPS)
         * lw['cm_norm_w'].astype(f32).reshape(CM_GROUPS, CM_GROUP_DIM))
    v = v.reshape(B, n, CM_CHUNK, CM_GROUPS, CM_GROUP_DIM)
    s = (jnp.einsum('gij,bnjgc->bnigc', lw['cm_ws'].astype(f32), v)
         + lw['cm_bs'].astype(f32).T[:, :, None])
    return u.astype(f32) * s.reshape(B, L, CM_WIDTH)


def _rwkv7_scan(r, w, k, v, a, b, s0):
    def step(s, inp):
        r_t, w_t, k_t, v_t, a_t, b_t = inp
        sa = jnp.einsum('bhvk,bhk->bhv', s, a_t)
        s = (s * w_t[:, :, None, :] + sa[..., None] * b_t[:, :, None, :]
             + v_t[..., None] * k_t[:, :, None, :])
        return s, jnp.einsum('bhvk,bhk->bhv', s, r_t)

    xs = tuple(jnp.moveaxis(t, 1, 0) for t in (r, w, k, v, a, b))
    s_final, y = lax.scan(step, s0, xs)
    return jnp.moveaxis(y, 0, 1), s_final


def _rwkv_branch(r, k, v, wl, al, lw, s0):
    B, L, _ = r.shape
    f32 = jnp.float32
    hn = (RW_HEADS, RW_HEAD_DIM)
    shp = lambda t: t.astype(f32).reshape(B, L, RW_HEADS, RW_HEAD_DIM)
    r, k, v = shp(r), shp(k), shp(v)
    w_log = -jax.nn.softplus(-(lw['rw_w0'].astype(f32)[:, None, None, :]
                               + jnp.einsum('blr,drc->dblc', jnp.tanh(wl.astype(f32)), lw['rw_w2'].astype(f32)))) - 0.5
    decay = jnp.exp(-jnp.exp(w_log)).reshape(N_DIR, B, L, RW_HEADS, RW_HEAD_DIM)
    iclr = jax.nn.sigmoid(lw['rw_a0'].astype(f32)[:, None, None, :]
                          + jnp.einsum('blr,drc->dblc', al.astype(f32), lw['rw_a2'].astype(f32)))
    iclr = iclr.reshape(N_DIR, B, L, RW_HEADS, RW_HEAD_DIM)
    kk = k * lw['rw_kk'].astype(f32).reshape(hn)
    kk = kk * lax.rsqrt(jnp.maximum(jnp.sum(kk * kk, axis=-1, keepdims=True), 1e-24))
    k_dir = k[None] * (1.0 + (iclr - 1.0) * lw['rw_ka'].astype(f32).reshape(hn))
    b_dir = kk[None] * iclr
    s0 = s0.astype(f32)
    flip = lambda t: jnp.flip(t, axis=1)
    y_f, s_f = _rwkv7_scan(r, decay[0], k_dir[0], v, -kk, b_dir[0], s0[:, 0])
    y_b, s_b = _rwkv7_scan(flip(r), flip(decay[1]), flip(k_dir[1]), flip(v), flip(-kk), flip(b_dir[1]), s0[:, 1])
    y = y_f + flip(y_b)
    mu = jnp.mean(y, axis=-1, keepdims=True)
    var = jnp.mean(jnp.square(y - mu), axis=-1, keepdims=True)
    y = (y - mu) * lax.rsqrt(var + RW_GN_EPS) * lw['rw_gn_w'].astype(f32).reshape(hn)
    bonus = jnp.sum(jnp.sum(r[None] * k_dir * lw['rw_rk'].astype(f32), axis=-1, keepdims=True), axis=0) * v
    y = y + bonus
    return y.reshape(B, L, RW_WIDTH), jnp.stack([s_f, s_b], axis=1)


def _mixer(h, lw, s0_gla, s0_rw, latent):
    z = h @ lw['w_in']
    (g_q, g_k, g_v, g_gate, g_lora, c_u, c_v, c_gate,
     r_r, r_k, r_v, r_gate, r_wl, r_al) = _split_cols(z)
    o_gla, s_gla = _gla_branch(g_q, g_k, g_v, g_lora, lw, s0_gla, latent)
    o_cm = _chunk_mlp_branch(c_u, c_v, lw)
    o_rw, s_rw = _rwkv_branch(r_r, r_k, r_v, r_wl, r_al, lw, s0_rw)
    o = jnp.concatenate([o_gla.astype(h.dtype) * jax.nn.silu(g_gate),
                         o_cm.astype(h.dtype) * jax.nn.silu(c_gate),
                         o_rw.astype(h.dtype) * jax.nn.silu(r_gate)], axis=-1)
    return o @ lw['w_out'], s_gla, s_rw


def setup_inputs(seed: int = 0) -> dict:
    key = jax.random.key(seed)
    ks = jax.random.split(key, 26)
    nrm = lambda k, shape, s: jax.random.normal(k, shape, jnp.float32) * s
    D = D_MODEL
    return {
        'x_prompt': nrm(ks[0], (BATCH, SEQ, D), 1.0),
        'x_sample': nrm(ks[1], (DEC_BATCH, DEC_SEQ, D), 1.0),
        'state_gla': nrm(ks[2], (DEC_BATCH, DEPTH, N_DIR, GLA_HEADS, GLA_DK, GLA_DV), 1.0),
        'state_rwkv': nrm(ks[3], (DEC_BATCH, DEPTH, N_DIR, RW_HEADS, RW_HEAD_DIM, RW_HEAD_DIM), 0.5),
        'c': nrm(ks[4], (DEC_BATCH, D), 1.0),
        'c_ctx': nrm(ks[5], (D,), 1.0),
        'w_mod': nrm(ks[6], (DEPTH, D, 3 * D), 0.5 * D ** -0.5),
        'b_mod': nrm(ks[7], (DEPTH, 3 * D), 0.02),
        'norm_w': 1.0 + nrm(ks[8], (DEPTH, D), 0.02),
        'w_in': nrm(ks[9], (DEPTH, D, IN_WIDTH), D ** -0.5),
        'w_out': nrm(ks[10], (DEPTH, MIX_WIDTH, D), MIX_WIDTH ** -0.5),
        'gla_a2': nrm(ks[11], (DEPTH, N_DIR, GLA_LORA, GLA_QK_WIDTH), GLA_LORA ** -0.5),
        'gla_a_bias': nrm(ks[12], (DEPTH, N_DIR, GLA_QK_WIDTH), 0.1),
        'gla_norm_w': 1.0 + nrm(ks[13], (DEPTH, GLA_WIDTH), 0.02),
        'cm_norm_w': 1.0 + nrm(ks[14], (DEPTH, CM_WIDTH), 0.02),
        'cm_ws': nrm(ks[15], (DEPTH, CM_GROUPS, CM_CHUNK, CM_CHUNK), CM_CHUNK ** -0.5),
        'cm_bs': 1.0 + nrm(ks[16], (DEPTH, CM_GROUPS, CM_CHUNK), 0.1),
        'rw_w0': nrm(ks[17], (DEPTH, N_DIR, RW_WIDTH), 0.5),
        'rw_w2': nrm(ks[18], (DEPTH, N_DIR, RW_DECAY_LORA, RW_WIDTH), 0.5 * RW_DECAY_LORA ** -0.5),
        'rw_a0': nrm(ks[19], (DEPTH, N_DIR, RW_WIDTH), 0.1),
        'rw_a2': nrm(ks[20], (DEPTH, N_DIR, RW_ICLR_LORA, RW_WIDTH), 0.5 * RW_ICLR_LORA ** -0.5),
        'rw_kk': 0.85 + nrm(ks[21], (DEPTH, RW_WIDTH), 0.02),
        'rw_ka': 1.0 + nrm(ks[22], (DEPTH, RW_WIDTH), 0.02),
        'rw_rk': nrm(ks[23], (DEPTH, RW_HEADS, RW_HEAD_DIM), 0.1),
        'rw_gn_w': 1.0 + nrm(ks[24], (DEPTH, RW_WIDTH), 0.02),
        'final_norm_w': 1.0 + nrm(ks[25], (D,), 0.02),
    }


def reference(x_prompt, x_sample, state_gla, state_rwkv, c, c_ctx, w_mod, b_mod, norm_w,
              w_in, w_out, gla_a2, gla_a_bias, gla_norm_w, cm_norm_w, cm_ws, cm_bs,
              rw_w0, rw_w2, rw_a0, rw_a2, rw_kk, rw_ka, rw_rk, rw_gn_w, final_norm_w):
    ctx, lat = x_prompt, x_sample
    b_ctx = ctx.shape[0]
    new_gla, new_rw = [], []
    for l in range(DEPTH):
        lw = {'w_in': w_in[l], 'w_out': w_out[l], 'gla_a2': gla_a2[l], 'gla_a_bias': gla_a_bias[l],
              'gla_norm_w': gla_norm_w[l], 'cm_norm_w': cm_norm_w[l], 'cm_ws': cm_ws[l], 'cm_bs': cm_bs[l],
              'rw_w0': rw_w0[l], 'rw_w2': rw_w2[l], 'rw_a0': rw_a0[l], 'rw_a2': rw_a2[l],
              'rw_kk': rw_kk[l], 'rw_ka': rw_ka[l], 'rw_rk': rw_rk[l], 'rw_gn_w': rw_gn_w[l]}
        shift, scale, gate = _modulation(c_ctx[None, :], w_mod[l], b_mod[l])
        h = _rmsnorm(ctx, norm_w[l]) * (1.0 + scale) + shift
        z_gla = jnp.zeros((b_ctx, N_DIR, GLA_HEADS, GLA_DK, GLA_DV), jnp.float32)
        z_rw = jnp.zeros((b_ctx, N_DIR, RW_HEADS, RW_HEAD_DIM, RW_HEAD_DIM), jnp.float32)
        out, s_gla, s_rw = _mixer(h, lw, z_gla, z_rw, latent=False)
        ctx = ctx + gate * out
        new_gla.append(s_gla)
        new_rw.append(s_rw)
        shift, scale, gate = _modulation(c, w_mod[l], b_mod[l])
        h = _rmsnorm(lat, norm_w[l]) * (1.0 + scale) + shift
        out, _, _ = _mixer(h, lw, state_gla[:, l], state_rwkv[:, l], latent=True)
        lat = lat + gate * out
    y_prompt = _rmsnorm(ctx, final_norm_w)
    y_sample = _rmsnorm(lat, final_norm_w)
    new_state_gla = jnp.stack(new_gla, axis=1)
    new_state_rwkv = jnp.stack(new_rw, axis=1)
    return (y_prompt, y_sample, new_state_gla, new_state_rwkv)
```

```cpp
#include <hip/hip_runtime.h>
#include <hip/hip_cooperative_groups.h>
#include <cstdio>
namespace cg = cooperative_groups;

#ifndef PROBE_REP
#define PROBE_REP 0
#endif
#ifndef PROBE_SUB
#define PROBE_SUB 31
#endif
#ifndef MULTI_LAUNCH
#define MULTI_LAUNCH 0
#endif

typedef _Float16 h16;
typedef _Float16 h16x8 __attribute__((ext_vector_type(8)));
typedef _Float16 h16x4 __attribute__((ext_vector_type(4)));
typedef _Float16 h16x2 __attribute__((ext_vector_type(2)));
typedef short s16x8 __attribute__((ext_vector_type(8)));
typedef float f32x4 __attribute__((ext_vector_type(4)));
typedef float f32x2 __attribute__((ext_vector_type(2)));
typedef unsigned u32x4 __attribute__((ext_vector_type(4)));
#define LAS __attribute__((address_space(3)))

constexpr int D = 2048, NTOK = 16384, NCTX = 8192, INW = 7056, INWP = 7168;
constexpr int LDS_BYTES = 147456;
constexpr int ZQ = 0, ZK = 384, ZV = 768, ZGG = 1536, ZLORA = 2304, ZCU = 2320, ZCV = 2832, ZCG = 3344,
              ZRR = 3856, ZRK = 4624, ZRV = 5392, ZRG = 6160, ZWL = 6928, ZAL = 6992;
constexpr size_t OUT_SG = (size_t)NTOK * D, OUT_SR = OUT_SG + 32ull * 2 * 2 * 6 * 64 * 128;

struct Params {
    const float *x_prompt, *x_sample, *state_gla, *state_rwkv, *c, *c_ctx, *w_mod, *b_mod, *norm_w, *w_in, *w_out,
        *gla_a2, *gla_a_bias, *gla_norm_w, *cm_norm_w, *cm_ws, *cm_bs, *rw_w0, *rw_w2, *rw_a0, *rw_a2, *rw_kk, *rw_ka, *rw_rk, *rw_gn_w, *final_norm_w;
    float* out;
    float* mod;
    unsigned* ctr;
    unsigned* bar;
    h16 *wT_in, *wT_out, *hbuf, *z, *gla_of, *gla_ob, *rw_yf, *rw_yb;
    float* bscal;
    h16* rwT;
    int ph_lo, ph_hi, sub, pad_;
};

__device__ __forceinline__ float silu_f(float x) { return x / (1.f + __expf(-x)); }
__device__ __forceinline__ float sigmoid_f(float x) { return 1.f / (1.f + __expf(-x)); }
template <int CTRL> __device__ __forceinline__ float dppf(float x) { return __int_as_float(__builtin_amdgcn_update_dpp(0, __float_as_int(x), CTRL, 0xF, 0xF, true)); }
__device__ __forceinline__ float red16(float x) { x += dppf<0xB1>(x); x += dppf<0x4E>(x); x += dppf<0x141>(x); x += dppf<0x140>(x); return x; }
__device__ __forceinline__ float red8(float x) { x += dppf<0xB1>(x); x += dppf<0x4E>(x); x += dppf<0x141>(x); return x; }
__device__ __forceinline__ float red64(float x) { x = red16(x); x += __shfl_xor(x, 16); x += __shfl_xor(x, 32); return x; }
__device__ __forceinline__ unsigned short f2bf(float f) { unsigned u = __float_as_uint(f); u += 0x7FFFu + ((u >> 16) & 1u); return (unsigned short)(u >> 16); }


#define XB_TMO      128
#define XB_XCNT(j)  (256  + 64 * (j))
#define XB_XSUB(j)  (1280 + 64 * (j))
#define XB_XGEN(j)  (2304 + 64 * (j))
#define XB_TOP      3328
#define XB_TOPGEN   3392
#define XCD_BAR_WORDS 3456
#define XB_SPIN_CAP (1u << 22)
__device__ __forceinline__ unsigned xb_ld(unsigned* p)              { return __hip_atomic_load(p, __ATOMIC_RELAXED, __HIP_MEMORY_SCOPE_AGENT); }
__device__ __forceinline__ unsigned xb_add(unsigned* p, unsigned v) { return __hip_atomic_fetch_add(p, v, __ATOMIC_RELAXED, __HIP_MEMORY_SCOPE_AGENT); }
__device__ __forceinline__ unsigned xb_xcc_id() { return (unsigned)__builtin_amdgcn_s_getreg((3 << 11) | 20) & 0xFu; }
#define XB_SPIN(cond, bar) do { unsigned _sp = 0; while (cond) { __builtin_amdgcn_s_sleep(1); \
    if ((++_sp & 255u) == 0u) { if (xb_ld(&(bar)[XB_TMO])) break; if (_sp > XB_SPIN_CAP) { atomicAdd(&(bar)[XB_TMO], 1u); break; } } } } while (0)
struct XcdBarrier { unsigned* bar; unsigned x; volatile LAS unsigned* st; };
__device__ __forceinline__ XcdBarrier xcd_barrier_post(unsigned* bar, volatile LAS unsigned* st) {
    XcdBarrier b; b.bar = bar; b.x = xb_xcc_id(); b.st = st;
    if (threadIdx.x == 0) (void)xb_add(&bar[XB_XCNT(b.x)], 1u);
    return b;
}
__device__ __forceinline__ void xcd_barrier_complete(unsigned* bar, unsigned x, unsigned& nloc, unsigned& nx) {
    const unsigned G = gridDim.x * gridDim.y * gridDim.z;
    unsigned sum, cnt, mine, sp = 0u;
    for (;;) {
        sum = 0u; cnt = 0u; mine = 0u;
#pragma unroll
        for (unsigned j = 0; j < 16; ++j) { const unsigned c = xb_ld(&bar[XB_XCNT(j)]); sum += c; cnt += (c > 0u) ? 1u : 0u; mine = (j == x) ? c : mine; }
        if (sum == G) break;
        __builtin_amdgcn_s_sleep(1);
        if ((++sp & 255u) == 0u) { if (xb_ld(&bar[XB_TMO])) break; if (sp > XB_SPIN_CAP) { atomicAdd(&bar[XB_TMO], 1u); break; } }
    }
    nloc = mine > 0u ? mine : 1u; nx = cnt > 0u ? cnt : 1u;
}
__device__ __forceinline__ void xcd_barrier(const XcdBarrier& b) {
    asm volatile("s_waitcnt vmcnt(0)" ::: "memory");
    __syncthreads();
    if (threadIdx.x == 0) {
        unsigned* bar = b.bar;
        __builtin_amdgcn_s_waitcnt(0);
        unsigned nloc = b.st[0], nx = b.st[1];
        if (nloc == 0u) { xcd_barrier_complete(bar, b.x, nloc, nx); b.st[0] = nloc; b.st[1] = nx; }
        const unsigned old = xb_add(&bar[XB_XSUB(b.x)], 1u);
        const unsigned gen = old / nloc;
        if (old + 1u == (gen + 1u) * nloc) {
            __builtin_amdgcn_fence(__ATOMIC_RELEASE, "agent");
            asm volatile("s_waitcnt vmcnt(0)" ::: "memory");
            const unsigned og = xb_add(&bar[XB_TOP], 1u);
            const unsigned tg = og / nx;
            if (og + 1u == (tg + 1u) * nx) xb_add(&bar[XB_TOPGEN], 1u);
            else XB_SPIN(xb_ld(&bar[XB_TOPGEN]) == tg, bar);
            __builtin_amdgcn_fence(__ATOMIC_ACQUIRE, "agent");
            xb_add(&bar[XB_XGEN(b.x)], 1u);
            asm volatile("s_waitcnt vmcnt(0)" ::: "memory");
        } else {
            XB_SPIN(xb_ld(&bar[XB_XGEN(b.x)]) == gen, bar);
            __builtin_amdgcn_fence(__ATOMIC_ACQUIRE, "agent");
            asm volatile("s_waitcnt vmcnt(0)" ::: "memory");
        }
    }
    __syncthreads();
}

namespace pg8 {
constexpr int BM = 256, BK = 64, HALF = 128, HTB = HALF * BK * 2, STAGE_BYTES = 8 * HTB, NXCD = 8, WGM = 4;
__host__ __device__ __forceinline__ int lds_byte(int r, int c) { const int st = (r >> 4) * 2 + (c >> 5), rr = r & 15, cc = c & 31, ob = rr * 64 + cc * 2; return st * 1024 + (ob ^ (((ob >> 9) & 1) << 5)); }
__host__ __device__ __forceinline__ void stage_rc(int b, int& R, int& C) { const int st = b / 1024, sb = b % 1024, swz = sb ^ (((sb >> 9) & 1) << 5); R = (st >> 1) * 16 + swz / 64; C = (st & 1) * 32 + (swz % 64) / 2; }
__host__ __device__ __forceinline__ int perm32(int rho) { const int n = rho >> 4, i = rho & 15; return 8 * (i >> 2) + 4 * n + (i & 3); }
struct Unit { int pm, pn; };
struct Gemm { const h16* A; const h16* Bt; int M, N, K; };
struct StaticOrder {
    int nM, nN, nwg, G, c, wgm;
    __host__ __device__ void init(int M, int N, int G_, int c_, int wgm_ = WGM) { nM = M / BM; nN = N / BM; nwg = nM * nN; G = G_; c = c_; wgm = wgm_; }
    __host__ __device__ bool next(int i, Unit& u) const {
        const long L = (long)i * G + c; if (L >= nwg) return false;
        int wgid = (int)L; { const int q = nwg / NXCD, r = nwg % NXCD, xcd = wgid % NXCD, off = wgid / NXCD; wgid = (xcd < r ? xcd * (q + 1) : r * (q + 1) + (xcd - r) * q) + off; }
        const int nig = wgm * nN, gid = wgid / nig, fm = gid * wgm, gsz = (nM - fm) < wgm ? (nM - fm) : wgm;
        u.pm = fm + ((wgid % nig) % gsz); u.pn = (wgid % nig) / gsz; return true;
    }
};

template <class Epi>
__device__ __forceinline__ void gemm_phase(LAS unsigned char* lds, const Gemm g, const StaticOrder& S, const Epi& E) {
    const int tid = threadIdx.x, wid = __builtin_amdgcn_readfirstlane(tid >> 6), lane = tid & 63, wr = wid >> 2, wc = wid & 3, fr = lane & 15, fq = lane >> 4;
    const int K = g.K, nt = K / BK;
    unsigned voffA[2], voffB[2];
#pragma unroll
    for (int i = 0; i < 2; ++i) { int R, C; stage_rc(tid * 16 + i * 8192, R, C); const int Rb = Epi::PERM ? ((R & ~31) + perm32(R & 31)) : R;
        voffA[i] = (unsigned)(R * K + C) * 2u; voffB[i] = (unsigned)(Rb * K + C) * 2u; }
    const size_t kstep = (size_t)(BK * 2);
    const size_t hstep = (size_t)HALF * K * 2;
    const size_t tstep = 2 * hstep;
    const unsigned ldsw = (unsigned)wid * 1024u;
    const int aoff = lds_byte(wr * 64 + fr, fq * 8), boff = lds_byte(wc * 32 + fr, fq * 8);
#define PG8_SA(b, h) (((b) * 2 + (h)) * HTB)
#define PG8_SB(b, h) ((4 + (b) * 2 + (h)) * HTB)
#define PG8_STAGE(bufoff, gbase, voff) do { _Pragma("unroll") for (int _i = 0; _i < 2; ++_i) \
        __builtin_amdgcn_global_load_lds((const unsigned*)((const char*)(gbase) + (voff)[_i]), (LAS unsigned*)(lds + (bufoff) + ldsw + _i * 8192), 16, 0, 0); } while (0)
#define PG8_LDA(dst, b, h) do { _Pragma("unroll") for (int m = 0; m < 4; ++m) _Pragma("unroll") for (int k = 0; k < 2; ++k) dst[m][k] = *(const LAS h16x8*)(lds + PG8_SA(b, h) + aoff + m * 2048 + k * 1024); } while (0)
#define PG8_LDB(dst, b, h) do { _Pragma("unroll") for (int n = 0; n < 2; ++n) _Pragma("unroll") for (int k = 0; k < 2; ++k) dst[n][k] = *(const LAS h16x8*)(lds + PG8_SB(b, h) + boff + n * 2048 + k * 1024); } while (0)
#define PG8_MMA(ai, bj, At, Bt) do { __builtin_amdgcn_s_setprio(1); _Pragma("unroll") for (int m = 0; m < 4; ++m) _Pragma("unroll") for (int n = 0; n < 2; ++n) _Pragma("unroll") for (int k = 0; k < 2; ++k) \
        acc[ai][bj][m][n] = __builtin_amdgcn_mfma_f32_16x16x32_f16(Bt[n][k], At[m][k], acc[ai][bj][m][n], 0, 0, 0); __builtin_amdgcn_s_setprio(0); } while (0)
#define PG8_WAIT_V(n) asm volatile("s_waitcnt vmcnt(" #n ")" ::: "memory")
#define PG8_WAIT_L(n) asm volatile("s_waitcnt lgkmcnt(" #n ")" ::: "memory")
#define PG8_BAR __builtin_amdgcn_s_barrier()
#define PG8_SCHED __builtin_amdgcn_sched_barrier(0)
    Unit cur, nxt; int ui = 0;
    if (!S.next(0, cur)) return;
    f32x4 acc[2][2][4][2];
#pragma unroll
    for (int a = 0; a < 2; ++a)
#pragma unroll
        for (int b = 0; b < 2; ++b)
#pragma unroll
            for (int m = 0; m < 4; ++m)
#pragma unroll
                for (int n = 0; n < 2; ++n) acc[a][b][m][n] = (f32x4){0.f, 0.f, 0.f, 0.f};
    h16x8 At[4][2], B0[2][2], B1[2][2];
    const char* cA = (const char*)g.A + (size_t)cur.pm * tstep; const char* cB = (const char*)g.Bt + (size_t)cur.pn * tstep;
    PG8_STAGE(PG8_SB(0, 0), cB, voffB); PG8_STAGE(PG8_SA(0, 0), cA, voffA); PG8_STAGE(PG8_SB(0, 1), cB + hstep, voffB); PG8_STAGE(PG8_SA(0, 1), cA + hstep, voffA);
    if (wr == 1) PG8_BAR;
    PG8_WAIT_V(4); PG8_BAR;
    PG8_STAGE(PG8_SB(1, 0), cB + kstep, voffB); PG8_STAGE(PG8_SA(1, 0), cA + kstep, voffA); PG8_STAGE(PG8_SB(1, 1), cB + hstep + kstep, voffB);
    PG8_WAIT_V(6); PG8_BAR;
    for (;;) {
        const bool has_next = S.next(ui + 1, nxt);
        const char* nA = has_next ? (const char*)g.A + (size_t)nxt.pm * tstep : cA; const char* nB = has_next ? (const char*)g.Bt + (size_t)nxt.pn * tstep : cB;
        for (int t = 0; t < nt; t += 2) {
            const bool last = (t == nt - 2);
            const char* a1 = cA + (size_t)(t + 1) * kstep;
            const char* a2 = last ? nA : cA + (size_t)(t + 2) * kstep; const char* b2 = last ? nB : cB + (size_t)(t + 2) * kstep;
            const char* a3 = a2 + kstep; const char* b3 = b2 + kstep;
            PG8_LDB(B0, 0, 0); PG8_SCHED; PG8_LDA(At, 0, 0); PG8_STAGE(PG8_SA(1, 1), a1 + hstep, voffA);
            PG8_WAIT_L(8); PG8_BAR; PG8_WAIT_L(0); PG8_MMA(0, 0, At, B0); PG8_BAR; PG8_SCHED;
            PG8_LDB(B1, 0, 1); PG8_STAGE(PG8_SB(0, 0), b2, voffB);
            PG8_BAR; PG8_WAIT_L(0); PG8_MMA(0, 1, At, B1); PG8_BAR;
            PG8_LDA(At, 0, 1); PG8_STAGE(PG8_SA(0, 0), a2, voffA);
            PG8_BAR; PG8_WAIT_L(0); PG8_MMA(1, 0, At, B0); PG8_BAR; PG8_SCHED;
            PG8_STAGE(PG8_SB(0, 1), b2 + hstep, voffB);
            PG8_WAIT_V(6); PG8_BAR; PG8_MMA(1, 1, At, B1); PG8_BAR;
            PG8_LDB(B0, 1, 0); PG8_SCHED; PG8_LDA(At, 1, 0); PG8_STAGE(PG8_SA(0, 1), a2 + hstep, voffA);
            PG8_WAIT_L(8); PG8_BAR; PG8_WAIT_L(0); PG8_MMA(0, 0, At, B0); PG8_BAR; PG8_SCHED;
            PG8_LDB(B1, 1, 1); PG8_STAGE(PG8_SB(1, 0), b3, voffB);
            PG8_BAR; PG8_WAIT_L(0); PG8_MMA(0, 1, At, B1); PG8_BAR;
            PG8_LDA(At, 1, 1); PG8_STAGE(PG8_SA(1, 0), a3, voffA);
            PG8_BAR; PG8_WAIT_L(0); PG8_MMA(1, 0, At, B0); PG8_BAR; PG8_SCHED;
            PG8_STAGE(PG8_SB(1, 1), b3 + hstep, voffB);
            PG8_WAIT_V(6); PG8_BAR; PG8_MMA(1, 1, At, B1); PG8_BAR;
        }
        E(acc, cur, wr, wc, fr, fq);
        if (!has_next) break;
#pragma unroll
        for (int a = 0; a < 2; ++a)
#pragma unroll
            for (int b = 0; b < 2; ++b)
#pragma unroll
                for (int m = 0; m < 4; ++m)
#pragma unroll
                    for (int n = 0; n < 2; ++n) acc[a][b][m][n] = (f32x4){0.f, 0.f, 0.f, 0.f};
        cur = nxt; cA = nA; cB = nB; ++ui;
    }
    PG8_WAIT_V(0);
    if (wr == 0) PG8_BAR;
    PG8_BAR;
#undef PG8_SA
#undef PG8_SB
#undef PG8_STAGE
#undef PG8_LDA
#undef PG8_LDB
#undef PG8_MMA
#undef PG8_WAIT_V
#undef PG8_WAIT_L
#undef PG8_BAR
#undef PG8_SCHED
}

struct EpiZ {
    static constexpr bool PERM = true;
    h16* Z;
    __device__ __forceinline__ void operator()(const f32x4 (&acc)[2][2][4][2], const Unit& u, int wr, int wc, int fr, int fq) const {
        const int row0 = u.pm * BM + wr * 64 + fr, col0 = u.pn * BM + wc * 32 + 8 * fq;
#pragma unroll
        for (int ai = 0; ai < 2; ++ai)
#pragma unroll
            for (int m = 0; m < 4; ++m) { h16* rowp = Z + (size_t)(row0 + ai * HALF + m * 16) * INW;
#pragma unroll
                for (int bj = 0; bj < 2; ++bj) { const int col = col0 + bj * HALF;
                    if (col < INW) { const f32x4 v0 = acc[ai][bj][m][0], v1 = acc[ai][bj][m][1];
                        h16x8 w; w[0] = (h16)v0[0]; w[1] = (h16)v0[1]; w[2] = (h16)v0[2]; w[3] = (h16)v0[3]; w[4] = (h16)v1[0]; w[5] = (h16)v1[1]; w[6] = (h16)v1[2]; w[7] = (h16)v1[3];
                        *(h16x8*)(rowp + col) = w; } } }
    }
};
struct EpiRes {
    static constexpr bool PERM = true;
    const h16* xin; h16* xout; const float* gate;
    __device__ __forceinline__ void operator()(const f32x4 (&acc)[2][2][4][2], const Unit& u, int wr, int wc, int fr, int fq) const {
        const int row0 = u.pm * BM + wr * 64 + fr, col0 = u.pn * BM + wc * 32 + 8 * fq;
        const int r00 = u.pm * BM, cond = r00 < NCTX ? 0 : 1 + ((r00 - NCTX) >> 11);
        const float* gr = gate + cond * 6144;
        f32x4 g0[2], g1[2];
#pragma unroll
        for (int bj = 0; bj < 2; ++bj) { g0[bj] = *(const f32x4*)(gr + col0 + bj * HALF); g1[bj] = *(const f32x4*)(gr + col0 + bj * HALF + 4); }
        h16x8 xv[2][4][2];
#pragma unroll
        for (int ai = 0; ai < 2; ++ai)
#pragma unroll
            for (int m = 0; m < 4; ++m)
#pragma unroll
                for (int bj = 0; bj < 2; ++bj) xv[ai][m][bj] = __builtin_nontemporal_load((const h16x8*)(xin + (size_t)(row0 + ai * HALF + m * 16) * D + col0 + bj * HALF));
#pragma unroll
        for (int ai = 0; ai < 2; ++ai)
#pragma unroll
            for (int m = 0; m < 4; ++m) { const int r = row0 + ai * HALF + m * 16;
#pragma unroll
                for (int bj = 0; bj < 2; ++bj) { const int c = col0 + bj * HALF;
                    const f32x4 v0 = acc[ai][bj][m][0], v1 = acc[ai][bj][m][1];
                    h16x8 w;
#pragma unroll
                    for (int e = 0; e < 4; ++e) { w[e] = (h16)((float)xv[ai][m][bj][e] + g0[bj][e] * v0[e]); w[4 + e] = (h16)((float)xv[ai][m][bj][4 + e] + g1[bj][e] * v1[e]); }
                    *(h16x8*)(xout + (size_t)r * D + c) = w; } }
    }
};
}

__device__ __forceinline__ void conv_tile(const float* src, int ld, int nvalid, h16* dst, int k0, int n0, float* tile  ) {
    const int tid = threadIdx.x;
    float v[16];
#pragma unroll
    for (int i = 0; i < 16; ++i) { const int e = tid + i * 512, kk = e >> 6, nn = e & 63;
        v[i] = (n0 + nn < nvalid) ? __builtin_nontemporal_load(src + (size_t)(k0 + kk) * ld + n0 + nn) : 0.f; }
#pragma unroll
    for (int i = 0; i < 16; ++i) { const int e = tid + i * 512, kk = e >> 6, nn = e & 63; tile[kk * 65 + nn] = v[i]; }
    __syncthreads();
    { const int nn = tid >> 3, ks = (tid & 7) * 16; h16x8 w0, w1;
#pragma unroll
        for (int j = 0; j < 8; ++j) { w0[j] = (h16)tile[(ks + j) * 65 + nn]; w1[j] = (h16)tile[(ks + 8 + j) * 65 + nn]; }
        *(h16x8*)(dst + (size_t)(n0 + nn) * 2048 + k0 + ks) = w0; *(h16x8*)(dst + (size_t)(n0 + nn) * 2048 + k0 + ks + 8) = w1; }
    __syncthreads();
}

__device__ void conv_win(const Params& p, int l, float* ldsf, int t0, int tstride) {
    for (int t = t0; t < 16 * 112; t += tstride) { const int kt = t & 15, ntile = t >> 4;
        conv_tile(p.w_in + (size_t)l * D * INW, INW, INW, p.wT_in, kt * 128, ntile * 64, ldsf); }
}

__device__ void phase_prologue(const Params& p, float* ldsf) {
    const int tid = threadIdx.x;
    for (int t = blockIdx.x; t < 192 + 1024 + 1792 + 96; t += gridDim.x) {
        if (t >= 192 + 1024 + 1792) {
            const int o8 = (t - (192 + 1024 + 1792)) * 512 + tid;
            const int j0 = (o8 & 7) * 8, c = (o8 >> 3) & 63, hh = (o8 >> 9) % 12, m = ((o8 >> 9) / 12) & 1, ld = (o8 >> 9) / 24;
            const float* src = (m ? p.rw_a2 : p.rw_w2) + (size_t)ld * 64 * 768 + hh * 64 + c;
            h16x8 w;
#pragma unroll
            for (int e = 0; e < 8; ++e) w[e] = (h16)src[(size_t)(j0 + e) * 768];
            *(h16x8*)(p.rwT + (size_t)o8 * 8) = w;
        } else if (t < 192) {
            const int l = t / 96, cc = (t % 96) * 64;
            float* sc = ldsf;
            float* red = ldsf + 5 * 2048;
            for (int i = tid; i < 5 * 2048; i += 512) { const int cnd = i >> 11, k = i & 2047; const float v = cnd == 0 ? p.c_ctx[k] : p.c[(cnd - 1) * 2048 + k]; sc[i] = silu_f(v); }
            __syncthreads();
            const int col = cc + (tid & 63), kg = tid >> 6;
            float a0 = 0, a1 = 0, a2 = 0, a3 = 0, a4 = 0;
            const float* wp = p.w_mod + (size_t)l * D * 6144 + col;
#pragma unroll 32
            for (int k = kg; k < 2048; k += 8) { const float w = __builtin_nontemporal_load(wp + (size_t)k * 6144);
                a0 += sc[k] * w; a1 += sc[2048 + k] * w; a2 += sc[4096 + k] * w; a3 += sc[6144 + k] * w; a4 += sc[8192 + k] * w; }
            red[(kg * 5 + 0) * 64 + (tid & 63)] = a0; red[(kg * 5 + 1) * 64 + (tid & 63)] = a1; red[(kg * 5 + 2) * 64 + (tid & 63)] = a2;
            red[(kg * 5 + 3) * 64 + (tid & 63)] = a3; red[(kg * 5 + 4) * 64 + (tid & 63)] = a4;
            __syncthreads();
            if (tid < 320) { const int cnd = tid >> 6, cl = tid & 63; float s = p.b_mod[l * 6144 + cc + cl];
#pragma unroll
                for (int g = 0; g < 8; ++g) s += red[(g * 5 + cnd) * 64 + cl];
                p.mod[(size_t)(l * 5 + cnd) * 6144 + cc + cl] = s; }
            __syncthreads();
        } else if (t < 192 + 1024) {
            const int u = t - 192, l = u >> 9, kt = u & 15, ntile = (u >> 4) & 31;
            conv_tile(p.w_out + (size_t)l * D * D, D, D, p.wT_out + (size_t)l * D * D, kt * 128, ntile * 64, ldsf);
        } else {
            const int u = t - 192 - 1024, kt = u & 15, ntile = u >> 4;
            conv_tile(p.w_in, INW, INW, p.wT_in, kt * 128, ntile * 64, ldsf);
        }
    }
}

__device__ __forceinline__ void load_row_f32(const float* xr, int lane, f32x4 (&xv)[8]) {
#pragma unroll
    for (int j = 0; j < 8; ++j) xv[j] = __builtin_nontemporal_load((const f32x4*)(xr + (j * 64 + lane) * 4));
}
__device__ __forceinline__ void load_row_h16_nt(const h16* xr, int lane, f32x4 (&xv)[8]) {
#pragma unroll
    for (int j = 0; j < 8; ++j) { const h16x4 t = __builtin_nontemporal_load((const h16x4*)(xr + (j * 64 + lane) * 4)); xv[j] = (f32x4){(float)t[0], (float)t[1], (float)t[2], (float)t[3]}; }
}
__device__ __forceinline__ void load_row_h16(const h16* xr, int lane, f32x4 (&xv)[8]) {
#pragma unroll
    for (int j = 0; j < 8; ++j) { const h16x4 t = *(const h16x4*)(xr + (j * 64 + lane) * 4); xv[j] = (f32x4){(float)t[0], (float)t[1], (float)t[2], (float)t[3]}; }
}
__device__ void phase_prep(const Params& p, int l) {
    const int lane = threadIdx.x & 63, wid = threadIdx.x >> 6;
    const float* nw = p.norm_w + l * D;
    h16* x0h = (h16*)p.out;
    const h16* x1h = (const h16*)p.out + (size_t)NTOK * D;
    const int stride = gridDim.x * 8;
    int r = blockIdx.x * 8 + wid;
    f32x4 xv[8], xn[8];
    auto load = [&](int rr, f32x4 (&dst)[8]) {
        if (l == 0) load_row_f32(rr < NCTX ? p.x_prompt + (size_t)rr * D : p.x_sample + (size_t)(rr - NCTX) * D, lane, dst);
        else load_row_h16_nt(x1h + (size_t)rr * D, lane, dst);
    };
    if (r < NTOK) load(r, xv);
    while (r < NTOK) {
        const int rn = r + stride;
        if (rn < NTOK) load(rn, xn);
        const int cond = r < NCTX ? 0 : 1 + ((r - NCTX) >> 11);
        const float* mb = p.mod + (size_t)(l * 5 + cond) * 6144;
        float ss = 0.f;
        if (l == 0) {
#pragma unroll
            for (int j = 0; j < 8; ++j) { h16x4 o; o[0] = (h16)xv[j][0]; o[1] = (h16)xv[j][1]; o[2] = (h16)xv[j][2]; o[3] = (h16)xv[j][3]; *(h16x4*)(x0h + (size_t)r * D + (j * 64 + lane) * 4) = o; } }
#pragma unroll
        for (int j = 0; j < 8; ++j) ss += xv[j][0] * xv[j][0] + xv[j][1] * xv[j][1] + xv[j][2] * xv[j][2] + xv[j][3] * xv[j][3];
        ss = red64(ss);
        const float rs = rsqrtf(ss * (1.f / 2048.f) + 1e-6f);
#pragma unroll
        for (int j = 0; j < 8; ++j) { const int k = (j * 64 + lane) * 4;
            const f32x4 w = *(const f32x4*)(nw + k), sh = *(const f32x4*)(mb + k), scl = *(const f32x4*)(mb + 2048 + k);
            h16x4 o;
#pragma unroll
            for (int e = 0; e < 4; ++e) o[e] = (h16)(xv[j][e] * rs * w[e] * (1.f + scl[e]) + sh[e]);
            *(h16x4*)(p.hbuf + (size_t)r * D + k) = o; }
#pragma unroll
        for (int j = 0; j < 8; ++j) xv[j] = xn[j];
        r = rn;
    }
}

__device__ void phase_final(const Params& p) {
    const int lane = threadIdx.x & 63, wid = threadIdx.x >> 6;
    const h16* x2h = p.gla_of;
    const int stride = gridDim.x * 8;
    int r = blockIdx.x * 8 + wid;
    f32x4 xv[8], xn[8];
    if (r < NTOK) load_row_h16_nt(x2h + (size_t)r * D, lane, xv);
    while (r < NTOK) {
        const int rn = r + stride;
        if (rn < NTOK) load_row_h16_nt(x2h + (size_t)rn * D, lane, xn);
        float* yr = p.out + (size_t)r * D;
        float ss = 0.f;
#pragma unroll
        for (int j = 0; j < 8; ++j) ss += xv[j][0] * xv[j][0] + xv[j][1] * xv[j][1] + xv[j][2] * xv[j][2] + xv[j][3] * xv[j][3];
        ss = red64(ss);
        const float rs = rsqrtf(ss * (1.f / 2048.f) + 1e-6f);
#pragma unroll
        for (int j = 0; j < 8; ++j) { const int k = (j * 64 + lane) * 4; const f32x4 w = *(const f32x4*)(p.final_norm_w + k);
            __builtin_nontemporal_store(xv[j] * rs * w, (f32x4*)(yr + k)); }
#pragma unroll
        for (int j = 0; j < 8; ++j) xv[j] = xn[j];
        r = rn;
    }
}

__device__ __forceinline__ float silu_fast(float x) { return x * __builtin_amdgcn_rcpf(1.f + __expf(-x)); }
__device__ void phase_combine(const Params& p, int l) {
    const int lane = threadIdx.x & 63, wid = threadIdx.x >> 6;
    const bool lo = lane < 32;
    int cg[2], cr[2], hd[2];
    cg[0] = (lane >> 4) * 128 + (lane & 15) * 8; cg[1] = lo ? (4 + (lane >> 4)) * 128 + (lane & 15) * 8 : 0;
    hd[0] = lane >> 3; hd[1] = lo ? 8 + (lane >> 3) : 0;
    cr[0] = hd[0] * 64 + (lane & 7) * 8; cr[1] = hd[1] * 64 + (lane & 7) * 8;
    f32x4 wg[2][2], wr[2][2];
#pragma unroll
    for (int ps = 0; ps < 2; ++ps) { wg[ps][0] = *(const f32x4*)(p.gla_norm_w + l * 768 + cg[ps]); wg[ps][1] = *(const f32x4*)(p.gla_norm_w + l * 768 + cg[ps] + 4);
        wr[ps][0] = *(const f32x4*)(p.rw_gn_w + l * 768 + cr[ps]); wr[ps][1] = *(const f32x4*)(p.rw_gn_w + l * 768 + cr[ps] + 4); }
    for (int r = blockIdx.x * 8 + wid; r < NTOK; r += gridDim.x * 8) {
        const h16* zr = p.z + (size_t)r * INW; h16* orow = p.hbuf + (size_t)r * D;
        h16x8 ga[2], gb[2], gg[2], ra[2], rb[2], rv[2], rg[2]; float bs[2];
        const h16x8 zero8 = {0, 0, 0, 0, 0, 0, 0, 0};
#pragma unroll
        for (int ps = 0; ps < 2; ++ps) {
            if (ps == 0 || lo) {
                ga[ps] = __builtin_nontemporal_load((const h16x8*)(p.gla_of + (size_t)r * 768 + cg[ps])); gb[ps] = __builtin_nontemporal_load((const h16x8*)(p.gla_ob + (size_t)r * 768 + cg[ps])); gg[ps] = __builtin_nontemporal_load((const h16x8*)(zr + ZGG + cg[ps]));
                ra[ps] = __builtin_nontemporal_load((const h16x8*)(p.rw_yf + (size_t)r * 768 + cr[ps])); rb[ps] = __builtin_nontemporal_load((const h16x8*)(p.rw_yb + (size_t)r * 768 + cr[ps]));
                rv[ps] = __builtin_nontemporal_load((const h16x8*)(zr + ZRV + cr[ps])); rg[ps] = __builtin_nontemporal_load((const h16x8*)(zr + ZRG + cr[ps]));
                bs[ps] = p.bscal[(size_t)r * 12 + hd[ps]] + p.bscal[(size_t)(NTOK + r) * 12 + hd[ps]];
            } else { ga[ps] = zero8; gb[ps] = zero8; gg[ps] = zero8; ra[ps] = zero8; rb[ps] = zero8; rv[ps] = zero8; rg[ps] = zero8; bs[ps] = 0.f; }
        }
#pragma unroll
        for (int ps = 0; ps < 2; ++ps) {
            float o[8]; float ss = 0.f;
#pragma unroll
            for (int e = 0; e < 8; ++e) { o[e] = (float)ga[ps][e] + (float)gb[ps][e]; ss += o[e] * o[e]; }
            ss = red16(ss);
            const float rs = rsqrtf(ss * (1.f / 128.f) + 1e-6f);
            h16x8 ov;
#pragma unroll
            for (int e = 0; e < 8; ++e) ov[e] = (h16)(o[e] * rs * (e < 4 ? wg[ps][0][e & 3] : wg[ps][1][e & 3]) * silu_fast((float)gg[ps][e]));
            if (ps == 0 || lo) *(h16x8*)(orow + cg[ps]) = ov;
        }
#pragma unroll
        for (int ps = 0; ps < 2; ++ps) {
            float y[8]; float sm = 0.f;
#pragma unroll
            for (int e = 0; e < 8; ++e) { y[e] = (float)ra[ps][e] + (float)rb[ps][e]; sm += y[e]; }
            const float mu = red8(sm) * (1.f / 64.f);
            float vs = 0.f;
#pragma unroll
            for (int e = 0; e < 8; ++e) { y[e] -= mu; vs += y[e] * y[e]; }
            const float rs = rsqrtf(red8(vs) * (1.f / 64.f) + 64e-5f);
            h16x8 ov;
#pragma unroll
            for (int e = 0; e < 8; ++e) ov[e] = (h16)((y[e] * rs * (e < 4 ? wr[ps][0][e & 3] : wr[ps][1][e & 3]) + bs[ps] * (float)rv[ps][e]) * silu_fast((float)rg[ps][e]));
            if (ps == 0 || lo) *(h16x8*)(orow + 1280 + cr[ps]) = ov;
        }
    }
}

__device__ __forceinline__ f32x4 mfma16(const h16x8 a, const h16x8 b, const f32x4 c) { return __builtin_amdgcn_mfma_f32_16x16x32_f16(a, b, c, 0, 0, 0); }
__device__ __forceinline__ f32x4 mfma16b(const s16x8 a, const s16x8 b, const f32x4 c) { return __builtin_amdgcn_mfma_f32_16x16x32_bf16(a, b, c, 0, 0, 0); }

__device__ void cm_unit(const Params& p, int l, int r0, int g, unsigned char* lds) {
    int tid_ = threadIdx.x; asm volatile("" : "+v"(tid_));
    const int tid = tid_, lane = tid & 63, wid = tid >> 6, fr = lane & 15, fq = lane >> 4;
    h16* Ws = (h16*)lds;
    h16* VnT = (h16*)(lds + 128 * 136 * 2);
    const float* ws = p.cm_ws + (size_t)(l * 4 + g) * 128 * 128;
    for (int e = tid; e < 128 * 32; e += 512) { const int i = e >> 5, j4 = (e & 31) * 4; const f32x4 v = *(const f32x4*)(ws + i * 128 + j4);
        h16x4 o; o[0] = (h16)v[0]; o[1] = (h16)v[1]; o[2] = (h16)v[2]; o[3] = (h16)v[3]; *(h16x4*)(Ws + i * 136 + j4) = o; }
    for (int j = wid; j < 128; j += 8) {
        const h16x2 v = *(const h16x2*)(p.z + (size_t)(r0 + j) * INW + ZCV + g * 128 + 2 * lane);
        const float v0 = (float)v[0], v1 = (float)v[1];
        const float rs = rsqrtf(red64(v0 * v0 + v1 * v1) * (1.f / 128.f) + 1e-6f);
        const f32x2 w = *(const f32x2*)(p.cm_norm_w + l * 512 + g * 128 + 2 * lane);
        VnT[(2 * lane) * 136 + j] = (h16)(v0 * rs * w[0]); VnT[(2 * lane + 1) * 136 + j] = (h16)(v1 * rs * w[1]);
    }
    __syncthreads();
    f32x4 acc[8];
#pragma unroll
    for (int ct = 0; ct < 8; ++ct) acc[ct] = (f32x4){0.f, 0.f, 0.f, 0.f};
#pragma unroll
    for (int ks = 0; ks < 4; ++ks) {
        const h16x8 a = *(const h16x8*)(Ws + (16 * wid + fr) * 136 + ks * 32 + fq * 8);
#pragma unroll
        for (int ct = 0; ct < 8; ++ct) { const h16x8 b = *(const h16x8*)(VnT + (ct * 16 + fr) * 136 + ks * 32 + fq * 8); acc[ct] = mfma16(b, a, acc[ct]); }
    }
    const int i = 16 * wid + fr; const float bias = p.cm_bs[(l * 4 + g) * 128 + i];
    const h16* zr = p.z + (size_t)(r0 + i) * INW; h16* orow = p.hbuf + (size_t)(r0 + i) * D + 768 + g * 128;
#pragma unroll
    for (int ct = 0; ct < 8; ++ct) { const int c = ct * 16 + fq * 4;
        const h16x4 u = *(const h16x4*)(zr + ZCU + g * 128 + c), gt = *(const h16x4*)(zr + ZCG + g * 128 + c);
        h16x4 o;
#pragma unroll
        for (int jj = 0; jj < 4; ++jj) o[jj] = (h16)((float)u[jj] * (acc[ct][jj] + bias) * silu_fast((float)gt[jj]));
        *(h16x4*)(orow + c) = o; }
    __syncthreads();
}

__device__ void gla_unit(const Params& p, int l, bool lat, int b, int h, int d, unsigned char* lds) {
    int tid_ = threadIdx.x; asm volatile("" : "+v"(tid_));
    const int tid = tid_, lane = tid & 63, wid = tid >> 6, fr = lane & 15, fq = lane >> 4;
    const int L = lat ? 2048 : 256, nch = L / 64;
    const int rbase = lat ? NCTX + b * 2048 : b * 256;
    h16* Qraw = (h16*)(lds);
    h16* Att = Qraw;
    h16* Kraw = (h16*)(lds + 9216);
    unsigned short* Qb = (unsigned short*)(lds + 2 * 9216);
    unsigned short* Kb = (unsigned short*)(lds + 3 * 9216);
    h16* Qh = (h16*)(lds + 4 * 9216);
    h16* KeT = (h16*)(lds + 5 * 9216);
    h16* Vt = (h16*)(lds + 6 * 9216);
    h16* St = (h16*)(lds + 6 * 9216 + 18432);
    float* Bc = (float*)(lds + 6 * 9216 + 2 * 18432);
    h16* A2T = (h16*)(Bc + 4096);
    h16* Lor = A2T + 64 * 24;
    h16* laT = Lor + 64 * 24;
    float* Abias = (float*)(laT + 64 * 72);
    float* Ebl = Abias + 64;
    float* Rc = Ebl + 64;
    float* Rs = Rc + 1024;
    for (int e = tid; e < 1024; e += 512) { const int r = e >> 6, kk = e & 63; A2T[kk * 24 + r] = (h16)p.gla_a2[((size_t)(l * 2 + d) * 16 + r) * 384 + h * 64 + kk]; }
    if (tid < 64) Abias[tid] = p.gla_a_bias[(l * 2 + d) * 384 + h * 64 + tid];
    if (lat) for (int e = tid; e < 1024; e += 512) { const int pos = e >> 4, c = e & 15; const float inv = __expf(-(float)c * (9.210340371976184f / 16.f)); float s, co; __sincosf((float)pos * inv, &s, &co); Rc[e] = co; Rs[e] = s; }
    f32x4 S[4];
    const float* s0 = lat ? p.state_gla + ((((size_t)b * 2 + l) * 2 + d) * 6 + h) * 64 * 128 : nullptr;
#pragma unroll
    for (int kt = 0; kt < 4; ++kt)
#pragma unroll
        for (int jj = 0; jj < 4; ++jj) S[kt][jj] = lat ? s0[(kt * 16 + fq * 4 + jj) * 128 + 16 * wid + fr] : 0.f;
    h16* obuf = d == 0 ? p.gla_of : p.gla_ob;
    const int prow = tid >> 3, pseg = tid & 7;
    h16x8 pq, pk, pv0, pv1, plo;
    auto tokof = [&](int n, int i) -> int { return d == 0 ? n * 64 + i : L - 64 * (n + 1) + 63 - i; };
    auto prefetch = [&](int n) {
        const h16* zr = p.z + (size_t)(rbase + tokof(n, prow)) * INW;
        pq = *(const h16x8*)(zr + ZQ + h * 64 + pseg * 8); pk = *(const h16x8*)(zr + ZK + h * 64 + pseg * 8);
        pv0 = *(const h16x8*)(zr + ZV + h * 128 + pseg * 16); pv1 = *(const h16x8*)(zr + ZV + h * 128 + pseg * 16 + 8);
        if (fq < 2) plo = *(const h16x8*)(p.z + (size_t)(rbase + tokof(n, (wid >> 1) * 16 + fr)) * INW + ZLORA + fq * 8);
    };
    prefetch(0);
    for (int n = 0; n < nch; ++n) {
        __syncthreads();
        *(h16x8*)(Qraw + prow * 72 + pseg * 8) = pq; *(h16x8*)(Kraw + prow * 72 + pseg * 8) = pk;
#pragma unroll
        for (int j = 0; j < 8; ++j) { Vt[(pseg * 16 + j) * 72 + prow] = pv0[j]; Vt[(pseg * 16 + 8 + j) * 72 + prow] = pv1[j]; }
#pragma unroll
        for (int kt = 0; kt < 4; ++kt) { h16x4 sv; sv[0] = (h16)S[kt][0]; sv[1] = (h16)S[kt][1]; sv[2] = (h16)S[kt][2]; sv[3] = (h16)S[kt][3];
            *(h16x4*)(St + (16 * wid + fr) * 72 + kt * 16 + fq * 4) = sv; }
        { const int it = wid >> 1; const h16x8 zero8 = {0, 0, 0, 0, 0, 0, 0, 0};
            const h16x8 lf = (fq < 2) ? plo : zero8;
#pragma unroll
            for (int t2 = 0; t2 < 2; ++t2) { const int kt = (wid & 1) * 2 + t2;
                const h16x8 af = (fq < 2) ? *(const h16x8*)(A2T + (kt * 16 + fr) * 24 + fq * 8) : zero8;
                const f32x4 zz = mfma16(af, lf, (f32x4){0.f, 0.f, 0.f, 0.f});
                const f32x4 bi = *(const f32x4*)(Abias + kt * 16 + fq * 4);
#pragma unroll
                for (int jj = 0; jj < 4; ++jj) { const float z1 = zz[jj] + bi[jj];
                    const float ls = fminf(z1, 0.f) - __logf(1.f + __expf(-fabsf(z1)));
                    laT[(kt * 16 + fq * 4 + jj) * 72 + it * 16 + fr] = (h16)fmaxf(ls * (1.f / 16.f), -1.f); } } }
        __syncthreads();
        if (n + 1 < nch) prefetch(n + 1);
        { const int it = wid >> 1; h16x8 lt[2];
#pragma unroll
            for (int kb = 0; kb < 2; ++kb)
#pragma unroll
                for (int e = 0; e < 8; ++e) lt[kb][e] = (kb * 32 + fq * 8 + e <= it * 16 + fr) ? (h16)1.f : (h16)0.f;
#pragma unroll
            for (int t2 = 0; t2 < 2; ++t2) { const int kt = (wid & 1) * 2 + t2; f32x4 bacc = (f32x4){0.f, 0.f, 0.f, 0.f};
#pragma unroll
                for (int kb = 0; kb < 2; ++kb) { const h16x8 lf = *(const h16x8*)(laT + (kt * 16 + fr) * 72 + kb * 32 + fq * 8); bacc = mfma16(lf, lt[kb], bacc); }
                *(f32x4*)(Bc + (it * 16 + fr) * 64 + kt * 16 + fq * 4) = bacc;
                if (it == 3 && fr == 15) { f32x4 eb; eb[0] = __expf(bacc[0]); eb[1] = __expf(bacc[1]); eb[2] = __expf(bacc[2]); eb[3] = __expf(bacc[3]); *(f32x4*)(Ebl + kt * 16 + fq * 4) = eb; } } }
        __syncthreads();
        { const int i = prow, a = pseg, k0 = a * 8;
            const h16x8 qo = *(const h16x8*)(Qraw + i * 72 + k0), ko = *(const h16x8*)(Kraw + i * 72 + k0);
            float qv[8], kv[8];
#pragma unroll
            for (int j = 0; j < 8; ++j) { qv[j] = (float)qo[j] * 0.125f; kv[j] = (float)ko[j]; }
            if (lat) {
                const h16x8 qp = *(const h16x8*)(Qraw + i * 72 + (k0 ^ 16)), kp = *(const h16x8*)(Kraw + i * 72 + (k0 ^ 16));
                const int tok = tokof(n, i); const int pos = (a < 4) ? (tok >> 6) : (tok & 63); const bool first = (a & 2) == 0; const int cb = (a & 1) * 8;
#pragma unroll
                for (int j = 0; j < 8; ++j) { const float co = Rc[pos * 16 + cb + j], si = Rs[pos * 16 + cb + j]; const float qpp = (float)qp[j] * 0.125f, kpp = (float)kp[j];
                    qv[j] = first ? (qv[j] * co - qpp * si) : (qpp * si + qv[j] * co);
                    kv[j] = first ? (kv[j] * co - kpp * si) : (kpp * si + kv[j] * co); }
            }
            s16x8 qb, kb; h16x8 qh;
#pragma unroll
            for (int j = 0; j < 8; ++j) { const float ee = __expf(Bc[i * 64 + k0 + j]);
                const float qt = qv[j] * ee, kt = kv[j] * __builtin_amdgcn_rcpf(ee), ke = kt * Ebl[k0 + j];
                qb[j] = (short)f2bf(qt); kb[j] = (short)f2bf(kt); qh[j] = (h16)qt; KeT[(k0 + j) * 72 + i] = (h16)ke; }
            *(s16x8*)(Qb + i * 72 + k0) = qb; *(s16x8*)(Kb + i * 72 + k0) = kb; *(h16x8*)(Qh + i * 72 + k0) = qh;
        }
        __syncthreads();
        f32x4 O[4];
#pragma unroll
        for (int it = 0; it < 4; ++it) O[it] = (f32x4){0.f, 0.f, 0.f, 0.f};
#pragma unroll
        for (int ks = 0; ks < 2; ++ks) { const h16x8 sb = *(const h16x8*)(St + (16 * wid + fr) * 72 + ks * 32 + fq * 8);
#pragma unroll
            for (int it = 0; it < 4; ++it) { const h16x8 qa = *(const h16x8*)(Qh + (it * 16 + fr) * 72 + ks * 32 + fq * 8); O[it] = mfma16(sb, qa, O[it]); } }
        { const int it = wid >> 1;
#pragma unroll
            for (int t2 = 0; t2 < 2; ++t2) { const int jt = (wid & 1) * 2 + t2; f32x4 at = (f32x4){0.f, 0.f, 0.f, 0.f};
                if (jt <= it) {
#pragma unroll
                    for (int ks = 0; ks < 2; ++ks) { const s16x8 qa = *(const s16x8*)(Qb + (it * 16 + fr) * 72 + ks * 32 + fq * 8), kb = *(const s16x8*)(Kb + (jt * 16 + fr) * 72 + ks * 32 + fq * 8);
                        at = mfma16b(kb, qa, at); } }
                h16x4 av;
#pragma unroll
                for (int jj = 0; jj < 4; ++jj) { const int i = it * 16 + fr, j = jt * 16 + fq * 4 + jj; av[jj] = (h16)((j <= i) ? at[jj] : 0.f); }
                *(h16x4*)(Att + (it * 16 + fr) * 72 + jt * 16 + fq * 4) = av; } }
        __syncthreads();
        { h16x8 vb[2];
#pragma unroll
            for (int ks = 0; ks < 2; ++ks) vb[ks] = *(const h16x8*)(Vt + (16 * wid + fr) * 72 + ks * 32 + fq * 8);
#pragma unroll
            for (int it = 0; it < 4; ++it)
#pragma unroll
                for (int ks = 0; ks < 2; ++ks) { const h16x8 aa = *(const h16x8*)(Att + (it * 16 + fr) * 72 + ks * 32 + fq * 8); O[it] = mfma16(vb[ks], aa, O[it]); }
#pragma unroll
            for (int kt = 0; kt < 4; ++kt) { const f32x4 bl = *(const f32x4*)(Ebl + kt * 16 + fq * 4);
                S[kt] = S[kt] * bl;
#pragma unroll
                for (int ks = 0; ks < 2; ++ks) { const h16x8 ka = *(const h16x8*)(KeT + (kt * 16 + fr) * 72 + ks * 32 + fq * 8); S[kt] = mfma16(ka, vb[ks], S[kt]); } }
        }
#pragma unroll
        for (int it = 0; it < 4; ++it) { const int tok = tokof(n, it * 16 + fr); h16x4 ov; ov[0] = (h16)O[it][0]; ov[1] = (h16)O[it][1]; ov[2] = (h16)O[it][2]; ov[3] = (h16)O[it][3];
            *(h16x4*)(obuf + (size_t)(rbase + tok) * 768 + h * 128 + 16 * wid + fq * 4) = ov; }
    }
    if (!lat) { float* so = p.out + OUT_SG + ((((size_t)b * 2 + l) * 2 + d) * 6 + h) * 64 * 128;
#pragma unroll
        for (int kt = 0; kt < 4; ++kt)
#pragma unroll
            for (int jj = 0; jj < 4; ++jj) __builtin_nontemporal_store(S[kt][jj], so + (kt * 16 + fq * 4 + jj) * 128 + 16 * wid + fr); }
    __syncthreads();
}

__device__ __forceinline__ h16x4 cvt4(const f32x4 a) { h16x4 r; r[0] = (h16)a[0]; r[1] = (h16)a[1]; r[2] = (h16)a[2]; r[3] = (h16)a[3]; return r; }
__device__ __forceinline__ f32x4 mm16(const h16x4 second, const h16x4 first, const f32x4 acc) {
    h16x8 f8, s8;
#pragma unroll
    for (int e = 0; e < 4; ++e) { f8[e] = first[e]; s8[e] = second[e]; f8[4 + e] = (h16)0.f; s8[4 + e] = (h16)0.f; }
    return __builtin_amdgcn_mfma_f32_16x16x32_f16(f8, s8, acc, 0, 0, 0); }
__device__ __forceinline__ f32x4 mm32(const h16x8 second, const h16x8 first, const f32x4 acc) { return __builtin_amdgcn_mfma_f32_16x16x32_f16(first, second, acc, 0, 0, 0); }
__device__ void rwkv_unit(const Params& p, int l, bool lat, int b, int h, int d, unsigned char* lds) {
    constexpr int T = 32;
    int tid_ = threadIdx.x; asm volatile("" : "+v"(tid_));
    const int tid = tid_, lane = tid & 63, wid = __builtin_amdgcn_readfirstlane(tid >> 6);
    const int L = lat ? 2048 : 256, nblk = L / T;
    const int rbase = lat ? NCTX + b * 2048 : b * 256;
    float* Wb = (float*)lds;
    h16* Hb = (h16*)(lds + 16384);
    h16* FR = (h16*)(lds + 57344);
    h16* OPa = (h16*)(lds + 75776);
    h16* OPt = (h16*)(lds + 75776 + 6 * T * 72 * 2);
    float* Gf = (float*)(lds + 75776 + 6 * T * 72 * 2 + 3 * 2 * 64 * 20 * 2);
    h16* ybuf = d == 0 ? p.rw_yf : p.rw_yb;
    float* bsc = p.bscal + (size_t)d * NTOK * 12;
    auto tokof = [&](int s) -> int { return d == 0 ? s : L - 1 - s; };
    const bool chain = wid < 4;
    const int fr = lane & 15, fq = lane >> 4;
    const int v0 = 16 * (wid & 3);
    f32x4 S[4];
    const int pw = wid & 3, ts = fr & 7, chalf = fr >> 3;
    if (chain) {
        if (lat) { const float* s0 = p.state_rwkv + ((((size_t)b * 2 + l) * 2 + d) * 12 + h) * 4096;
#pragma unroll
            for (int kt = 0; kt < 4; ++kt) S[kt] = *(const f32x4*)(s0 + (v0 + fr) * 64 + kt * 16 + fq * 4);
        } else {
#pragma unroll
            for (int kt = 0; kt < 4; ++kt) S[kt] = (f32x4){0.f, 0.f, 0.f, 0.f}; }
    } else {
    }
    h16x8 pwl[2], pal[2]; h16x4 prv[2], pkv[2], pvv[2];
    auto pf_load = [&](int nb) {
        const h16* zr = p.z + (size_t)(rbase + tokof(nb * T + pw * 8 + ts)) * INW;
#pragma unroll
        for (int kb = 0; kb < 2; ++kb) { pwl[kb] = *(const h16x8*)(zr + ZWL + kb * 32 + fq * 8); pal[kb] = *(const h16x8*)(zr + ZAL + kb * 32 + fq * 8); }
#pragma unroll
        for (int u = 0; u < 2; ++u) { const int c = h * 64 + (2 * chalf + u) * 16 + fq * 4;
            prv[u] = *(const h16x4*)(zr + ZRR + c); pkv[u] = *(const h16x4*)(zr + ZRK + c); pvv[u] = *(const h16x4*)(zr + ZRV + c); }
    };
    auto prepare = [&](int nb, bool active) {
        h16x8 twf[2], alf[2]; h16x4 rv4[2], kv4[2], vv4[2];
        const int i = pw * 8 + ts; int tok = 0;
        f32x4 dwa[4], daa[4];
        if (active) {
            tok = tokof(nb * T + i);
            h16x8 w2f[4][2], a2f[4][2];
#pragma unroll
            for (int ct = 0; ct < 4; ++ct)
#pragma unroll
                for (int kb = 0; kb < 2; ++kb) { w2f[ct][kb] = *(const h16x8*)(FR + (ct * 16 + fr) * 72 + kb * 32 + fq * 8); a2f[ct][kb] = *(const h16x8*)(FR + (64 + ct * 16 + fr) * 72 + kb * 32 + fq * 8); }
#pragma unroll
            for (int kb = 0; kb < 2; ++kb) { alf[kb] = pal[kb];
                typedef unsigned u32x4_t __attribute__((ext_vector_type(4)));
                typedef unsigned u32x2_t __attribute__((ext_vector_type(2)));
                const u32x4_t raw = __builtin_bit_cast(u32x4_t, pwl[kb]);
                u32x2_t sel; sel[0] = chalf ? raw[2] : raw[0]; sel[1] = chalf ? raw[3] : raw[1];
                const h16x4 src = __builtin_bit_cast(h16x4, sel);
                h16x4 mine;
#pragma unroll
                for (int e = 0; e < 4; ++e) { const float x = (float)src[e]; const float e2 = __expf(2.f * x); mine[e] = (h16)(1.f - 2.f * __builtin_amdgcn_rcpf(e2 + 1.f)); }
                const u32x2_t mu = __builtin_bit_cast(u32x2_t, mine);
                u32x2_t ou; ou[0] = (unsigned)__builtin_amdgcn_update_dpp(0, (int)mu[0], 0x128, 0xF, 0xF, true); ou[1] = (unsigned)__builtin_amdgcn_update_dpp(0, (int)mu[1], 0x128, 0xF, 0xF, true);
                u32x4_t res; res[0] = chalf ? ou[0] : mu[0]; res[1] = chalf ? ou[1] : mu[1]; res[2] = chalf ? mu[0] : ou[0]; res[3] = chalf ? mu[1] : ou[1];
                twf[kb] = __builtin_bit_cast(h16x8, res); }
#pragma unroll
            for (int u = 0; u < 2; ++u) { rv4[u] = prv[u]; kv4[u] = pkv[u]; vv4[u] = pvv[u]; }
            if (nb + 1 < nblk) pf_load(nb + 1);
#pragma unroll
            for (int ct = 0; ct < 4; ++ct) { dwa[ct] = (f32x4){0.f, 0.f, 0.f, 0.f}; daa[ct] = dwa[ct];
#pragma unroll
                for (int kb = 0; kb < 2; ++kb) { dwa[ct] = mm32(twf[kb], w2f[ct][kb], dwa[ct]); daa[ct] = mm32(alf[kb], a2f[ct][kb], daa[ct]); } }
        }
        __syncthreads();
        if (!active) return;
        float* wbw = Wb + (nb & 1) * T * 64; h16* hbw = Hb + (nb & 1) * 5 * T * 64;
        float cw0[8], ca0[8], ckk[8], cka[8], crk[8];
#pragma unroll
        for (int u = 0; u < 2; ++u) { const int hc = h * 64 + (2 * chalf + u) * 16 + fq * 4;
            const f32x4 t0 = *(const f32x4*)(p.rw_w0 + (l * 2 + d) * 768 + hc), t1 = *(const f32x4*)(p.rw_a0 + (l * 2 + d) * 768 + hc),
                        t2 = *(const f32x4*)(p.rw_kk + l * 768 + hc), t3 = *(const f32x4*)(p.rw_ka + l * 768 + hc), t4 = *(const f32x4*)(p.rw_rk + l * 768 + hc);
#pragma unroll
            for (int jj = 0; jj < 4; ++jj) { cw0[u * 4 + jj] = t0[jj]; ca0[u * 4 + jj] = t1[jj]; ckk[u * 4 + jj] = t2[jj]; cka[u * 4 + jj] = t3[jj]; crk[u * 4 + jj] = t4[jj]; } }
        float dec[8], kd[8], kkv[8], icv[8], rr[8];
        float nrm = 0.f, bon = 0.f;
#pragma unroll
        for (int u = 0; u < 2; ++u) {
            const f32x4 dwsel = chalf ? dwa[2 + u] : dwa[u], dasel = chalf ? daa[2 + u] : daa[u];
#pragma unroll
            for (int jj = 0; jj < 4; ++jj) { const int q = u * 4 + jj;
                const float aw = cw0[q] + dwsel[jj], aa = ca0[q] + dasel[jj];
                dec[q] = __expf(-0.60653065971f * __builtin_amdgcn_rcpf(1.f + __expf(-aw)));
                icv[q] = __builtin_amdgcn_rcpf(1.f + __expf(-aa));
                const float kraw = (float)kv4[u][jj]; rr[q] = (float)rv4[u][jj];
                kkv[q] = kraw * ckk[q]; nrm += kkv[q] * kkv[q];
                kd[q] = kraw * (1.f + (icv[q] - 1.f) * cka[q]);
                bon += rr[q] * kd[q] * crk[q]; } }
        nrm += dppf<0x128>(nrm); bon += dppf<0x128>(bon);
        nrm += __shfl_xor(nrm, 16); bon += __shfl_xor(bon, 16);
        nrm += __shfl_xor(nrm, 32); bon += __shfl_xor(bon, 32);
        const float rn = rsqrtf(fmaxf(nrm, 1e-24f));
#pragma unroll
        for (int u = 0; u < 2; ++u) { const int c = (2 * chalf + u) * 16 + fq * 4; const int o = i * 64 + c;
            f32x4 wq; h16x4 kq, aq, bq, rq, vq;
#pragma unroll
            for (int jj = 0; jj < 4; ++jj) { const int q = u * 4 + jj; const float kk = kkv[q] * rn;
                wq[jj] = dec[q]; kq[jj] = (h16)kd[q]; aq[jj] = (h16)(-kk); bq[jj] = (h16)(kk * icv[q]); }
            rq = rv4[u]; vq = vv4[u];
            *(f32x4*)(wbw + o) = wq; *(h16x4*)(hbw + 0 * T * 64 + o) = kq; *(h16x4*)(hbw + 1 * T * 64 + o) = aq;
            *(h16x4*)(hbw + 2 * T * 64 + o) = bq; *(h16x4*)(hbw + 3 * T * 64 + o) = rq; *(h16x4*)(hbw + 4 * T * 64 + o) = vq; }
        if (lane == ts) bsc[(size_t)(rbase + tok) * 12 + h] = bon;
    };
    __syncthreads();
    for (int e = tid; e < 2 * 64 * 8; e += 512) { const int m = e >> 9, c = (e >> 3) & 63, j8 = (e & 7) * 8;
        *(h16x8*)(FR + (m * 64 + c) * 72 + j8) = *(const h16x8*)(p.rwT + ((size_t)((l * 2 + d) * 2 + m) * 12 + h) * 4096 + c * 64 + j8); }
    __syncthreads();
    if (!chain) { pf_load(0); prepare(0, true); } else __syncthreads();
    __syncthreads();
    for (int nb = 0; nb < nblk; ++nb) {
        if (chain) {
            { const float* bw = Wb + (nb & 1) * T * 64; const h16* hb = Hb + (nb & 1) * 5 * T * 64;
                const int gl = tid & 255, c2 = gl & 31, q = (gl >> 5) & 1, qt = gl >> 6, c = 2 * c2;
                f32x2 G[16]; { f32x2 run = (f32x2){1.f, 1.f};
#pragma unroll
                    for (int t = 0; t < 16; ++t) { run = run * *(const f32x2*)(bw + (16 * q + t) * 64 + c); G[t] = run; } }
                const f32x2 gref = G[7], gend = G[15];
                f32x2 iref; iref[0] = __builtin_amdgcn_rcpf(gref[0]); iref[1] = __builtin_amdgcn_rcpf(gref[1]);
#pragma unroll
                for (int t = 0; t < 16; ++t) {
                    if ((t >> 2) == qt) {
                        const int i = 16 * q + t; const f32x2 g = G[t], gm1 = t ? G[t - 1] : (f32x2){1.f, 1.f};
                        f32x2 ig; ig[0] = __builtin_amdgcn_rcpf(g[0]); ig[1] = __builtin_amdgcn_rcpf(g[1]);
                        const h16x2 k2 = *(const h16x2*)(hb + 0 * T * 64 + i * 64 + c), a2 = *(const h16x2*)(hb + 1 * T * 64 + i * 64 + c), b2 = *(const h16x2*)(hb + 2 * T * 64 + i * 64 + c),
                                    r2 = *(const h16x2*)(hb + 3 * T * 64 + i * 64 + c), v2 = *(const h16x2*)(hb + 4 * T * 64 + i * 64 + c);
                        const f32x2 kv_ = (f32x2){(float)k2[0], (float)k2[1]}, av = (f32x2){(float)a2[0], (float)a2[1]}, bv = (f32x2){(float)b2[0], (float)b2[1]}, rv = (f32x2){(float)r2[0], (float)r2[1]};
                        const f32x2 at = av * gm1, rt = rv * g, bs = bv * ig, ks_ = kv_ * ig;
                        const f32x2 ah_ = at * iref, rh_ = rt * iref, bh_ = bs * gref, kh_ = ks_ * gref, bb_ = bs * gend, kb_ = ks_ * gend;
                        h16x2 o;
                        o[0] = (h16)at[0]; o[1] = (h16)at[1]; *(h16x2*)(OPa + (0 * T + i) * 72 + c) = o;
                        o[0] = (h16)rt[0]; o[1] = (h16)rt[1]; *(h16x2*)(OPa + (1 * T + i) * 72 + c) = o;
                        o[0] = (h16)ah_[0]; o[1] = (h16)ah_[1]; *(h16x2*)(OPa + (2 * T + i) * 72 + c) = o;
                        o[0] = (h16)rh_[0]; o[1] = (h16)rh_[1]; *(h16x2*)(OPa + (3 * T + i) * 72 + c) = o;
                        o[0] = (h16)bh_[0]; o[1] = (h16)bh_[1]; *(h16x2*)(OPa + (4 * T + i) * 72 + c) = o;
                        o[0] = (h16)kh_[0]; o[1] = (h16)kh_[1]; *(h16x2*)(OPa + (5 * T + i) * 72 + c) = o;
                        OPt[((0 * 2 + q) * 64 + c) * 20 + t] = (h16)bb_[0]; OPt[((0 * 2 + q) * 64 + c + 1) * 20 + t] = (h16)bb_[1];
                        OPt[((1 * 2 + q) * 64 + c) * 20 + t] = (h16)kb_[0]; OPt[((1 * 2 + q) * 64 + c + 1) * 20 + t] = (h16)kb_[1];
                        OPt[((2 * 2 + q) * 64 + c) * 20 + t] = v2[0]; OPt[((2 * 2 + q) * 64 + c + 1) * 20 + t] = v2[1];
                    } }
                if (qt == 0) *(f32x2*)(Gf + q * 64 + c) = gend; }
            __syncthreads();
#pragma unroll
            for (int q = 0; q < 2; ++q) {
                const int row = 16 * q + fr;
                h16x8 ah[2], bh[2], kh[2], rh[2];
#pragma unroll
                for (int kb = 0; kb < 2; ++kb) { ah[kb] = *(const h16x8*)(OPa + (2 * T + row) * 72 + kb * 32 + fq * 8); rh[kb] = *(const h16x8*)(OPa + (3 * T + row) * 72 + kb * 32 + fq * 8);
                    bh[kb] = *(const h16x8*)(OPa + (4 * T + row) * 72 + kb * 32 + fq * 8); kh[kb] = *(const h16x8*)(OPa + (5 * T + row) * 72 + kb * 32 + fq * 8); }
                const f32x4 zero4 = (f32x4){0.f, 0.f, 0.f, 0.f};
                f32x4 NT = zero4, N = zero4, MakT = zero4, NabT = zero4, NakT = zero4;
#pragma unroll
                for (int kb = 0; kb < 2; ++kb) { NT = mm32(ah[kb], bh[kb], NT); N = mm32(bh[kb], ah[kb], N); MakT = mm32(ah[kb], kh[kb], MakT);
                    NabT = mm32(rh[kb], bh[kb], NabT); NakT = mm32(rh[kb], kh[kb], NakT); }
                f32x4 TT;
#pragma unroll
                for (int jj = 0; jj < 4; ++jj) { const int n = fq * 4 + jj, m = fr;
                    NT[jj] = (n < m) ? NT[jj] : 0.f; N[jj] = (m < n) ? N[jj] : 0.f; MakT[jj] = (n < m) ? MakT[jj] : 0.f;
                    NabT[jj] = (n <= m) ? NabT[jj] : 0.f; NakT[jj] = (n <= m) ? NakT[jj] : 0.f;
                    TT[jj] = NT[jj] + ((n == m) ? 1.f : 0.f); }
                { h16x4 pn = cvt4(N), pt = cvt4(NT);
                    f32x4 N2 = mm16(pn, pt, zero4), N2T = mm16(pt, pn, zero4);
                    TT = mm16(cvt4(TT), cvt4(N2), TT);
                    pn = cvt4(N2); pt = cvt4(N2T);
                    f32x4 N4 = mm16(pn, pt, zero4), N4T = mm16(pt, pn, zero4);
                    TT = mm16(cvt4(TT), cvt4(N4), TT);
                    const f32x4 N8 = mm16(cvt4(N4), cvt4(N4T), zero4);
                    TT = mm16(cvt4(TT), cvt4(N8), TT); }
                h16x8 sf[2];
#pragma unroll
                for (int kb = 0; kb < 2; ++kb)
#pragma unroll
                    for (int e = 0; e < 4; ++e) { sf[kb][e] = (h16)S[2 * kb][e]; sf[kb][4 + e] = (h16)S[2 * kb + 1][e]; }
                h16x8 atp[2], rtp[2];
#pragma unroll
                for (int kb = 0; kb < 2; ++kb) { const h16x4 a0 = *(const h16x4*)(OPa + (0 * T + row) * 72 + (2 * kb) * 16 + fq * 4), a1 = *(const h16x4*)(OPa + (0 * T + row) * 72 + (2 * kb + 1) * 16 + fq * 4);
                    const h16x4 r0 = *(const h16x4*)(OPa + (1 * T + row) * 72 + (2 * kb) * 16 + fq * 4), r1 = *(const h16x4*)(OPa + (1 * T + row) * 72 + (2 * kb + 1) * 16 + fq * 4);
#pragma unroll
                    for (int e = 0; e < 4; ++e) { atp[kb][e] = a0[e]; atp[kb][4 + e] = a1[e]; rtp[kb][e] = r0[e]; rtp[kb][4 + e] = r1[e]; } }
                const h16x4 vt4 = *(const h16x4*)(OPt + ((2 * 2 + q) * 64 + v0 + fr) * 20 + fq * 4);
                f32x4 X = zero4, Y = zero4;
#pragma unroll
                for (int kb = 0; kb < 2; ++kb) { X = mm32(sf[kb], atp[kb], X); Y = mm32(sf[kb], rtp[kb], Y); }
                X = mm16(vt4, cvt4(MakT), X);
                const f32x4 SA = mm16(cvt4(X), cvt4(TT), zero4);
                const h16x4 sa4 = cvt4(SA);
                Y = mm16(sa4, cvt4(NabT), Y);
                Y = mm16(vt4, cvt4(NakT), Y);
#pragma unroll
                for (int kt = 0; kt < 4; ++kt) { const f32x4 g = *(const f32x4*)(Gf + q * 64 + kt * 16 + fq * 4);
                    const h16x4 bb = *(const h16x4*)(OPt + ((0 * 2 + q) * 64 + kt * 16 + fr) * 20 + fq * 4), kb4 = *(const h16x4*)(OPt + ((1 * 2 + q) * 64 + kt * 16 + fr) * 20 + fq * 4);
                    f32x4 acc = S[kt] * g; acc = mm16(sa4, bb, acc); S[kt] = mm16(vt4, kb4, acc); }
#pragma unroll
                for (int jj = 0; jj < 4; ++jj) { const int tok = tokof(nb * T + 16 * q + fq * 4 + jj);
                    ybuf[(size_t)(rbase + tok) * 768 + h * 64 + v0 + fr] = (h16)Y[jj]; }
            }
        } else {
            prepare(nb + 1, nb + 1 < nblk);
        }
        __syncthreads();
    }
    if (chain && !lat) { float* so = p.out + OUT_SR + ((((size_t)b * 2 + l) * 2 + d) * 12 + h) * 4096;
#pragma unroll
        for (int kt = 0; kt < 4; ++kt) __builtin_nontemporal_store(S[kt], (f32x4*)(so + (v0 + fr) * 64 + kt * 16 + fq * 4)); }
    __syncthreads();
}

constexpr int NI_RWL = 96, NI_GLL = 48, NI_RWC = 768, NI_GLC = 384, NI_CM = 512, NI_TOTAL = NI_RWL + NI_GLL + NI_RWC + NI_GLC + NI_CM;

__device__ void phase_mixers(const Params& p, int l, unsigned char* lds, int cidx) {
    volatile int& s_item = *(volatile int*)(lds + 147440);
    for (;;) {
        if (threadIdx.x == 0) s_item = (int)atomicAdd(p.ctr + cidx, 1u);
        __syncthreads();
        int it = s_item;
        if (it >= NI_TOTAL) break;
        { const int ty = it < NI_RWL ? 1 : it < NI_RWL + NI_GLL ? 2 : it < NI_RWL + NI_GLL + NI_RWC ? 4 : it < NI_RWL + NI_GLL + NI_RWC + NI_GLC ? 8 : 16; if (!(p.sub & ty)) { __syncthreads(); continue; } }
#ifndef NO_RWKV
        if (it < NI_RWL) { rwkv_unit(p, l, true, it / 24, (it % 24) >> 1, it & 1, lds); continue; }
#endif
        it -= NI_RWL;
#ifndef NO_GLA
        if (it < NI_GLL) { gla_unit(p, l, true, it / 12, (it % 12) >> 1, it & 1, lds); continue; }
#endif
        it -= NI_GLL;
#ifndef NO_RWKV
        if (it < NI_RWC) { rwkv_unit(p, l, false, it / 24, (it % 24) >> 1, it & 1, lds); continue; }
#endif
        it -= NI_RWC;
#ifndef NO_GLA
        if (it < NI_GLC) { gla_unit(p, l, false, it / 12, (it % 12) >> 1, it & 1, lds); continue; }
#endif
        it -= NI_GLC;
#ifndef NO_CM
        cm_unit(p, l, (it >> 2) * 128, it & 3, lds);
#endif
    }
}

constexpr int NPHASE = 12;
template <int L> __device__ __forceinline__ void run_gemm1(const Params& p, unsigned char* lds) {
    pg8::Gemm g{p.hbuf, p.wT_in, NTOK, INWP, D}; pg8::StaticOrder S; S.init(NTOK, INWP, gridDim.x, blockIdx.x); pg8::EpiZ E{p.z};
    pg8::gemm_phase((LAS unsigned char*)lds, g, S, E);
}
template <int L> __device__ __forceinline__ void run_gemm2(const Params& p, unsigned char* lds) {
    pg8::Gemm g{p.hbuf, p.wT_out + (size_t)L * D * D, NTOK, D, D}; pg8::StaticOrder S; S.init(NTOK, D, gridDim.x, blockIdx.x, 8);
    h16* slotA = (h16*)p.out; h16* slotB = (h16*)p.out + (size_t)NTOK * D;
    pg8::EpiRes E{L == 0 ? slotA : slotB, L == 0 ? slotB : p.gla_of, p.mod + (size_t)L * 5 * 6144 + 4096};
    pg8::gemm_phase((LAS unsigned char*)lds, g, S, E);
}
#define RUN_PHASE(K, BODY) if (p.ph_lo <= (K) && (K) < p.ph_hi) { BODY; if ((K) + 1 < p.ph_hi) xcd_barrier(xb); }
__global__ void __launch_bounds__(512, 2) mega(Params p) {
    extern __shared__ __attribute__((aligned(16))) unsigned char lds[];
    cg::grid_group grid = cg::this_grid();
    uint4& xb_words = *(uint4*)(lds + 147424);
    if (threadIdx.x == 0) xb_words = make_uint4(0u, 0u, 0u, 0u);
    __syncthreads();
    XcdBarrier xb; xb.bar = p.bar; xb.x = 0; xb.st = (volatile LAS unsigned*)&xb_words;
    if (p.ph_hi - p.ph_lo > 1) xb = xcd_barrier_post(p.bar, (volatile LAS unsigned*)&xb_words);
    if (p.ph_lo > 1000) grid.sync();
    RUN_PHASE(0, phase_prologue(p, (float*)lds))
    RUN_PHASE(1, phase_prep(p, 0))
    RUN_PHASE(2, run_gemm1<0>(p, lds))
    RUN_PHASE(3, phase_mixers(p, 0, lds, 0))
    RUN_PHASE(4, phase_combine(p, 0); conv_win(p, 1, (float*)lds, blockIdx.x, gridDim.x))
    RUN_PHASE(5, run_gemm2<0>(p, lds))
    RUN_PHASE(6, phase_prep(p, 1))
    RUN_PHASE(7, run_gemm1<1>(p, lds))
    RUN_PHASE(8, phase_mixers(p, 1, lds, 1))
    RUN_PHASE(9, phase_combine(p, 1))
    RUN_PHASE(10, run_gemm2<1>(p, lds))
    RUN_PHASE(11, phase_final(p))
#ifdef PROBE_SYNC
    for (int i = 0; i < PROBE_SYNC; ++i) grid.sync();
#endif
}

extern "C" void kernel_launch(void* const* d_in, const int* in_sizes, int n_in, void* d_out, int out_size, void* d_ws, size_t ws_size, hipStream_t stream) {
    static int grid_blocks = 0;
    if (!grid_blocks) {
        int dev = 0, cus = 0, per_cu = 0;
        hipGetDevice(&dev);
        hipDeviceGetAttribute(&cus, hipDeviceAttributeMultiprocessorCount, dev);
        hipFuncSetAttribute((const void*)mega, hipFuncAttributeMaxDynamicSharedMemorySize, LDS_BYTES);
        hipOccupancyMaxActiveBlocksPerMultiprocessor(&per_cu, (const void*)mega, 512, LDS_BYTES);
        if (per_cu < 1) per_cu = 1;
        grid_blocks = cus * per_cu;
    }
    Params p{};
    const float** pin = (const float**)&p;
    for (int i = 0; i < 26; ++i) pin[i] = (const float*)d_in[i];
    p.out = (float*)d_out;
    unsigned char* ws = (unsigned char*)d_ws;
    size_t off = 0;
    auto take = [&](size_t bytes) { unsigned char* r = ws + off; off += (bytes + 255) & ~(size_t)255; return r; };
    p.bar = (unsigned*)take(XCD_BAR_WORDS * 4);
    p.ctr = (unsigned*)take(256);
    p.mod = (float*)take(2 * 5 * 6144 * 4);
    p.bscal = (float*)take((size_t)2 * NTOK * 12 * 4);
    p.rwT = (h16*)take((size_t)2 * 2 * 2 * 12 * 64 * 64 * 2);
    p.wT_in = (h16*)take((size_t)INWP * D * 2);
    p.wT_out = (h16*)take((size_t)2 * D * D * 2);
    p.hbuf = (h16*)take((size_t)NTOK * D * 2);
    p.z = (h16*)take((size_t)NTOK * INW * 2);
    p.gla_of = (h16*)take((size_t)NTOK * 768 * 2);
    p.gla_ob = (h16*)take((size_t)NTOK * 768 * 2);
    p.rw_yf = (h16*)take((size_t)NTOK * 768 * 2);
    p.rw_yb = (h16*)take((size_t)NTOK * 768 * 2);
    if (off > ws_size) { fprintf(stderr, "workspace too small: need %zu have %zu\n", off, ws_size); return; }
    hipMemsetAsync(p.bar, 0, ((XCD_BAR_WORDS * 4 + 255) & ~255) + 256, stream);
#if MULTI_LAUNCH
    for (int ph = 0; ph < NPHASE; ++ph) { p.ph_lo = ph; p.ph_hi = ph + 1;
        const int reps = ((PROBE_REP >> ph) & 1) ? 2 : 1;
        for (int r = 0; r < reps; ++r) { if (r) hipMemsetAsync(p.ctr, 0, 256, stream); p.sub = r ? PROBE_SUB : 31;
            hipLaunchKernelGGL(mega, dim3(grid_blocks), dim3(512), LDS_BYTES, stream, p); } }
#else
    p.ph_lo = 0; p.ph_hi = NPHASE; p.sub = 31;
    void* args[] = {&p};
    hipError_t e = hipLaunchCooperativeKernel((const void*)mega, dim3(grid_blocks), dim3(512), args, LDS_BYTES, stream);
    if (e != hipSuccess) fprintf(stderr, "cooperative launch failed: %s (grid %d)\n", hipGetErrorString(e), grid_blocks);
#endif
}
```

```cpp
#include <hip/hip_runtime.h>
#include <hip/hip_cooperative_groups.h>
#include <cstdio>
namespace cg = cooperative_groups;

#ifndef PROBE_REP
#define PROBE_REP 0
#endif
#ifndef PROBE_SUB
#define PROBE_SUB 31
#endif
#ifndef MULTI_LAUNCH
#define MULTI_LAUNCH 0
#endif

typedef _Float16 h16;
typedef _Float16 h16x8 __attribute__((ext_vector_type(8)));
typedef _Float16 h16x4 __attribute__((ext_vector_type(4)));
typedef _Float16 h16x2 __attribute__((ext_vector_type(2)));
typedef short s16x8 __attribute__((ext_vector_type(8)));
typedef float f32x4 __attribute__((ext_vector_type(4)));
typedef float f32x2 __attribute__((ext_vector_type(2)));
typedef unsigned u32x4 __attribute__((ext_vector_type(4)));
#define LAS __attribute__((address_space(3)))

constexpr int D = 2048, NTOK = 16384, NCTX = 8192, INW = 7056, INWP = 7168;
constexpr int LDS_BYTES = 147456;
constexpr int ZQ = 0, ZK = 384, ZV = 768, ZGG = 1536, ZLORA = 2304, ZCU = 2320, ZCV = 2832, ZCG = 3344,
              ZRR = 3856, ZRK = 4624, ZRV = 5392, ZRG = 6160, ZWL = 6928, ZAL = 6992;
constexpr size_t OUT_SG = (size_t)NTOK * D, OUT_SR = OUT_SG + 32ull * 2 * 2 * 6 * 64 * 128;

struct Params {
    const float *x_prompt, *x_sample, *state_gla, *state_rwkv, *c, *c_ctx, *w_mod, *b_mod, *norm_w, *w_in, *w_out,
        *gla_a2, *gla_a_bias, *gla_norm_w, *cm_norm_w, *cm_ws, *cm_bs, *rw_w0, *rw_w2, *rw_a0, *rw_a2, *rw_kk, *rw_ka, *rw_rk, *rw_gn_w, *final_norm_w;
    float* out;
    float* mod;
    unsigned* ctr;
    unsigned* bar;
    h16 *wT_in, *wT_out, *hbuf, *z, *gla_of, *gla_ob, *rw_yf, *rw_yb;
    float* bscal;
    h16* rwT;
    int ph_lo, ph_hi, sub, pad_;
};

__device__ __forceinline__ float silu_f(float x) { return x / (1.f + __expf(-x)); }
__device__ __forceinline__ float sigmoid_f(float x) { return 1.f / (1.f + __expf(-x)); }
template <int CTRL> __device__ __forceinline__ float dppf(float x) { return __int_as_float(__builtin_amdgcn_update_dpp(0, __float_as_int(x), CTRL, 0xF, 0xF, true)); }
__device__ __forceinline__ float red16(float x) { x += dppf<0xB1>(x); x += dppf<0x4E>(x); x += dppf<0x141>(x); x += dppf<0x140>(x); return x; }
__device__ __forceinline__ float red8(float x) { x += dppf<0xB1>(x); x += dppf<0x4E>(x); x += dppf<0x141>(x); return x; }
__device__ __forceinline__ float red64(float x) { x = red16(x); x += __shfl_xor(x, 16); x += __shfl_xor(x, 32); return x; }
__device__ __forceinline__ unsigned short f2bf(float f) { unsigned u = __float_as_uint(f); u += 0x7FFFu + ((u >> 16) & 1u); return (unsigned short)(u >> 16); }


#define XB_TMO      128
#define XB_XCNT(j)  (256  + 64 * (j))
#define XB_XSUB(j)  (1280 + 64 * (j))
#define XB_XGEN(j)  (2304 + 64 * (j))
#define XB_TOP      3328
#define XB_TOPGEN   3392
#define XCD_BAR_WORDS 3456
#define XB_SPIN_CAP (1u << 22)
__device__ __forceinline__ unsigned xb_ld(unsigned* p)              { return __hip_atomic_load(p, __ATOMIC_RELAXED, __HIP_MEMORY_SCOPE_AGENT); }
__device__ __forceinline__ unsigned xb_add(unsigned* p, unsigned v) { return __hip_atomic_fetch_add(p, v, __ATOMIC_RELAXED, __HIP_MEMORY_SCOPE_AGENT); }
__device__ __forceinline__ unsigned xb_xcc_id() { return (unsigned)__builtin_amdgcn_s_getreg((3 << 11) | 20) & 0xFu; }
#define XB_SPIN(cond, bar) do { unsigned _sp = 0; while (cond) { __builtin_amdgcn_s_sleep(1); \
    if ((++_sp & 255u) == 0u) { if (xb_ld(&(bar)[XB_TMO])) break; if (_sp > XB_SPIN_CAP) { atomicAdd(&(bar)[XB_TMO], 1u); break; } } } } while (0)
struct XcdBarrier { unsigned* bar; unsigned x; volatile LAS unsigned* st; };
__device__ __forceinline__ XcdBarrier xcd_barrier_post(unsigned* bar, volatile LAS unsigned* st) {
    XcdBarrier b; b.bar = bar; b.x = xb_xcc_id(); b.st = st;
    if (threadIdx.x == 0) (void)xb_add(&bar[XB_XCNT(b.x)], 1u);
    return b;
}
__device__ __forceinline__ void xcd_barrier_complete(unsigned* bar, unsigned x, unsigned& nloc, unsigned& nx) {
    const unsigned G = gridDim.x * gridDim.y * gridDim.z;
    unsigned sum, cnt, mine, sp = 0u;
    for (;;) {
        sum = 0u; cnt = 0u; mine = 0u;
#pragma unroll
        for (unsigned j = 0; j < 16; ++j) { const unsigned c = xb_ld(&bar[XB_XCNT(j)]); sum += c; cnt += (c > 0u) ? 1u : 0u; mine = (j == x) ? c : mine; }
        if (sum == G) break;
        __builtin_amdgcn_s_sleep(1);
        if ((++sp & 255u) == 0u) { if (xb_ld(&bar[XB_TMO])) break; if (sp > XB_SPIN_CAP) { atomicAdd(&bar[XB_TMO], 1u); break; } }
    }
    nloc = mine > 0u ? mine : 1u; nx = cnt > 0u ? cnt : 1u;
}
__device__ __forceinline__ void xcd_barrier(const XcdBarrier& b) {
    asm volatile("s_waitcnt vmcnt(0)" ::: "memory");
    __syncthreads();
    if (threadIdx.x == 0) {
        unsigned* bar = b.bar;
        __builtin_amdgcn_s_waitcnt(0);
        unsigned nloc = b.st[0], nx = b.st[1];
        if (nloc == 0u) { xcd_barrier_complete(bar, b.x, nloc, nx); b.st[0] = nloc; b.st[1] = nx; }
        const unsigned old = xb_add(&bar[XB_XSUB(b.x)], 1u);
        const unsigned gen = old / nloc;
        if (old + 1u == (gen + 1u) * nloc) {
            __builtin_amdgcn_fence(__ATOMIC_RELEASE, "agent");
            asm volatile("s_waitcnt vmcnt(0)" ::: "memory");
            const unsigned og = xb_add(&bar[XB_TOP], 1u);
            const unsigned tg = og / nx;
            if (og + 1u == (tg + 1u) * nx) xb_add(&bar[XB_TOPGEN], 1u);
            else XB_SPIN(xb_ld(&bar[XB_TOPGEN]) == tg, bar);
            __builtin_amdgcn_fence(__ATOMIC_ACQUIRE, "agent");
            xb_add(&bar[XB_XGEN(b.x)], 1u);
            asm volatile("s_waitcnt vmcnt(0)" ::: "memory");
        } else {
            XB_SPIN(xb_ld(&bar[XB_XGEN(b.x)]) == gen, bar);
            __builtin_amdgcn_fence(__ATOMIC_ACQUIRE, "agent");
            asm volatile("s_waitcnt vmcnt(0)" ::: "memory");
        }
    }
    __syncthreads();
}

namespace pg8 {
constexpr int BM = 256, BK = 64, HALF = 128, HTB = HALF * BK * 2, STAGE_BYTES = 8 * HTB, NXCD = 8, WGM = 4;
__host__ __device__ __forceinline__ int lds_byte(int r, int c) { const int st = (r >> 4) * 2 + (c >> 5), rr = r & 15, cc = c & 31, ob = rr * 64 + cc * 2; return st * 1024 + (ob ^ (((ob >> 9) & 1) << 5)); }
__host__ __device__ __forceinline__ void stage_rc(int b, int& R, int& C) { const int st = b / 1024, sb = b % 1024, swz = sb ^ (((sb >> 9) & 1) << 5); R = (st >> 1) * 16 + swz / 64; C = (st & 1) * 32 + (swz % 64) / 2; }
__host__ __device__ __forceinline__ int perm32(int rho) { const int n = rho >> 4, i = rho & 15; return 8 * (i >> 2) + 4 * n + (i & 3); }
struct Unit { int pm, pn; };
struct Gemm { const h16* A; const h16* Bt; int M, N, K; };
struct StaticOrder {
    int nM, nN, nwg, G, c, wgm;
    __host__ __device__ void init(int M, int N, int G_, int c_, int wgm_ = WGM) { nM = M / BM; nN = N / BM; nwg = nM * nN; G = G_; c = c_; wgm = wgm_; }
    __host__ __device__ bool next(int i, Unit& u) const {
        const long L = (long)i * G + c; if (L >= nwg) return false;
        int wgid = (int)L; { const int q = nwg / NXCD, r = nwg % NXCD, xcd = wgid % NXCD, off = wgid / NXCD; wgid = (xcd < r ? xcd * (q + 1) : r * (q + 1) + (xcd - r) * q) + off; }
        const int nig = wgm * nN, gid = wgid / nig, fm = gid * wgm, gsz = (nM - fm) < wgm ? (nM - fm) : wgm;
        u.pm = fm + ((wgid % nig) % gsz); u.pn = (wgid % nig) / gsz; return true;
    }
};

template <class Epi>
__device__ __forceinline__ void gemm_phase(LAS unsigned char* lds, const Gemm g, const StaticOrder& S, const Epi& E) {
    const int tid = threadIdx.x, wid = __builtin_amdgcn_readfirstlane(tid >> 6), lane = tid & 63, wr = wid >> 2, wc = wid & 3, fr = lane & 15, fq = lane >> 4;
    const int K = g.K, nt = K / BK;
    unsigned voffA[2], voffB[2];
#pragma unroll
    for (int i = 0; i < 2; ++i) { int R, C; stage_rc(tid * 16 + i * 8192, R, C); const int Rb = Epi::PERM ? ((R & ~31) + perm32(R & 31)) : R;
        voffA[i] = (unsigned)(R * K + C) * 2u; voffB[i] = (unsigned)(Rb * K + C) * 2u; }
    const size_t kstep = (size_t)(BK * 2);
    const size_t hstep = (size_t)HALF * K * 2;
    const size_t tstep = 2 * hstep;
    const unsigned ldsw = (unsigned)wid * 1024u;
    const int aoff = lds_byte(wr * 64 + fr, fq * 8), boff = lds_byte(wc * 32 + fr, fq * 8);
#define PG8_SA(b, h) (((b) * 2 + (h)) * HTB)
#define PG8_SB(b, h) ((4 + (b) * 2 + (h)) * HTB)
#define PG8_STAGE(bufoff, gbase, voff) do { _Pragma("unroll") for (int _i = 0; _i < 2; ++_i) \
        __builtin_amdgcn_global_load_lds((const unsigned*)((const char*)(gbase) + (voff)[_i]), (LAS unsigned*)(lds + (bufoff) + ldsw + _i * 8192), 16, 0, 0); } while (0)
#define PG8_LDA(dst, b, h) do { _Pragma("unroll") for (int m = 0; m < 4; ++m) _Pragma("unroll") for (int k = 0; k < 2; ++k) dst[m][k] = *(const LAS h16x8*)(lds + PG8_SA(b, h) + aoff + m * 2048 + k * 1024); } while (0)
#define PG8_LDB(dst, b, h) do { _Pragma("unroll") for (int n = 0; n < 2; ++n) _Pragma("unroll") for (int k = 0; k < 2; ++k) dst[n][k] = *(const LAS h16x8*)(lds + PG8_SB(b, h) + boff + n * 2048 + k * 1024); } while (0)
#define PG8_MMA(ai, bj, At, Bt) do { __builtin_amdgcn_s_setprio(1); _Pragma("unroll") for (int m = 0; m < 4; ++m) _Pragma("unroll") for (int n = 0; n < 2; ++n) _Pragma("unroll") for (int k = 0; k < 2; ++k) \
        acc[ai][bj][m][n] = __builtin_amdgcn_mfma_f32_16x16x32_f16(Bt[n][k], At[m][k], acc[ai][bj][m][n], 0, 0, 0); __builtin_amdgcn_s_setprio(0); } while (0)
#define PG8_WAIT_V(n) asm volatile("s_waitcnt vmcnt(" #n ")" ::: "memory")
#define PG8_WAIT_L(n) asm volatile("s_waitcnt lgkmcnt(" #n ")" ::: "memory")
#define PG8_BAR __builtin_amdgcn_s_barrier()
#define PG8_SCHED __builtin_amdgcn_sched_barrier(0)
    Unit cur, nxt; int ui = 0;
    if (!S.next(0, cur)) return;
    f32x4 acc[2][2][4][2];
#pragma unroll
    for (int a = 0; a < 2; ++a)
#pragma unroll
        for (int b = 0; b < 2; ++b)
#pragma unroll
            for (int m = 0; m < 4; ++m)
#pragma unroll
                for (int n = 0; n < 2; ++n) acc[a][b][m][n] = (f32x4){0.f, 0.f, 0.f, 0.f};
    h16x8 At[4][2], B0[2][2], B1[2][2];
    const char* cA = (const char*)g.A + (size_t)cur.pm * tstep; const char* cB = (const char*)g.Bt + (size_t)cur.pn * tstep;
    PG8_STAGE(PG8_SB(0, 0), cB, voffB); PG8_STAGE(PG8_SA(0, 0), cA, voffA); PG8_STAGE(PG8_SB(0, 1), cB + hstep, voffB); PG8_STAGE(PG8_SA(0, 1), cA + hstep, voffA);
    if (wr == 1) PG8_BAR;
    PG8_WAIT_V(4); PG8_BAR;
    PG8_STAGE(PG8_SB(1, 0), cB + kstep, voffB); PG8_STAGE(PG8_SA(1, 0), cA + kstep, voffA); PG8_STAGE(PG8_SB(1, 1), cB + hstep + kstep, voffB);
    PG8_WAIT_V(6); PG8_BAR;
    for (;;) {
        const bool has_next = S.next(ui + 1, nxt);
        const char* nA = has_next ? (const char*)g.A + (size_t)nxt.pm * tstep : cA; const char* nB = has_next ? (const char*)g.Bt + (size_t)nxt.pn * tstep : cB;
        for (int t = 0; t < nt; t += 2) {
            const bool last = (t == nt - 2);
            const char* a1 = cA + (size_t)(t + 1) * kstep;
            const char* a2 = last ? nA : cA + (size_t)(t + 2) * kstep; const char* b2 = last ? nB : cB + (size_t)(t + 2) * kstep;
            const char* a3 = a2 + kstep; const char* b3 = b2 + kstep;
            PG8_LDB(B0, 0, 0); PG8_SCHED; PG8_LDA(At, 0, 0); PG8_STAGE(PG8_SA(1, 1), a1 + hstep, voffA);
            PG8_WAIT_L(8); PG8_BAR; PG8_WAIT_L(0); PG8_MMA(0, 0, At, B0); PG8_BAR; PG8_SCHED;
            PG8_LDB(B1, 0, 1); PG8_STAGE(PG8_SB(0, 0), b2, voffB);
            PG8_BAR; PG8_WAIT_L(0); PG8_MMA(0, 1, At, B1); PG8_BAR;
            PG8_LDA(At, 0, 1); PG8_STAGE(PG8_SA(0, 0), a2, voffA);
            PG8_BAR; PG8_WAIT_L(0); PG8_MMA(1, 0, At, B0); PG8_BAR; PG8_SCHED;
            PG8_STAGE(PG8_SB(0, 1), b2 + hstep, voffB);
            PG8_WAIT_V(6); PG8_BAR; PG8_MMA(1, 1, At, B1); PG8_BAR;
            PG8_LDB(B0, 1, 0); PG8_SCHED; PG8_LDA(At, 1, 0); PG8_STAGE(PG8_SA(0, 1), a2 + hstep, voffA);
            PG8_WAIT_L(8); PG8_BAR; PG8_WAIT_L(0); PG8_MMA(0, 0, At, B0); PG8_BAR; PG8_SCHED;
            PG8_LDB(B1, 1, 1); PG8_STAGE(PG8_SB(1, 0), b3, voffB);
            PG8_BAR; PG8_WAIT_L(0); PG8_MMA(0, 1, At, B1); PG8_BAR;
            PG8_LDA(At, 1, 1); PG8_STAGE(PG8_SA(1, 0), a3, voffA);
            PG8_BAR; PG8_WAIT_L(0); PG8_MMA(1, 0, At, B0); PG8_BAR; PG8_SCHED;
            PG8_STAGE(PG8_SB(1, 1), b3 + hstep, voffB);
            PG8_WAIT_V(6); PG8_BAR; PG8_MMA(1, 1, At, B1); PG8_BAR;
        }
        E(acc, cur, wr, wc, fr, fq);
        if (!has_next) break;
#pragma unroll
        for (int a = 0; a < 2; ++a)
#pragma unroll
            for (int b = 0; b < 2; ++b)
#pragma unroll
                for (int m = 0; m < 4; ++m)
#pragma unroll
                    for (int n = 0; n < 2; ++n) acc[a][b][m][n] = (f32x4){0.f, 0.f, 0.f, 0.f};
        cur = nxt; cA = nA; cB = nB; ++ui;
    }
    PG8_WAIT_V(0);
    if (wr == 0) PG8_BAR;
    PG8_BAR;
#undef PG8_SA
#undef PG8_SB
#undef PG8_STAGE
#undef PG8_LDA
#undef PG8_LDB
#undef PG8_MMA
#undef PG8_WAIT_V
#undef PG8_WAIT_L
#undef PG8_BAR
#undef PG8_SCHED
}

struct EpiZ {
    static constexpr bool PERM = true;
    h16* Z;
    __device__ __forceinline__ void operator()(const f32x4 (&acc)[2][2][4][2], const Unit& u, int wr, int wc, int fr, int fq) const {
        const int row0 = u.pm * BM + wr * 64 + fr, col0 = u.pn * BM + wc * 32 + 8 * fq;
#pragma unroll
        for (int ai = 0; ai < 2; ++ai)
#pragma unroll
            for (int m = 0; m < 4; ++m) { h16* rowp = Z + (size_t)(row0 + ai * HALF + m * 16) * INW;
#pragma unroll
                for (int bj = 0; bj < 2; ++bj) { const int col = col0 + bj * HALF;
                    if (col < INW) { const f32x4 v0 = acc[ai][bj][m][0], v1 = acc[ai][bj][m][1];
                        h16x8 w; w[0] = (h16)v0[0]; w[1] = (h16)v0[1]; w[2] = (h16)v0[2]; w[3] = (h16)v0[3]; w[4] = (h16)v1[0]; w[5] = (h16)v1[1]; w[6] = (h16)v1[2]; w[7] = (h16)v1[3];
                        *(h16x8*)(rowp + col) = w; } } }
    }
};
struct EpiRes {
    static constexpr bool PERM = true;
    const h16* xin; h16* xout; const float* gate;
    __device__ __forceinline__ void operator()(const f32x4 (&acc)[2][2][4][2], const Unit& u, int wr, int wc, int fr, int fq) const {
        const int row0 = u.pm * BM + wr * 64 + fr, col0 = u.pn * BM + wc * 32 + 8 * fq;
        const int r00 = u.pm * BM, cond = r00 < NCTX ? 0 : 1 + ((r00 - NCTX) >> 11);
        const float* gr = gate + cond * 6144;
        f32x4 g0[2], g1[2];
#pragma unroll
        for (int bj = 0; bj < 2; ++bj) { g0[bj] = *(const f32x4*)(gr + col0 + bj * HALF); g1[bj] = *(const f32x4*)(gr + col0 + bj * HALF + 4); }
        h16x8 xv[2][4][2];
#pragma unroll
        for (int ai = 0; ai < 2; ++ai)
#pragma unroll
            for (int m = 0; m < 4; ++m)
#pragma unroll
                for (int bj = 0; bj < 2; ++bj) xv[ai][m][bj] = __builtin_nontemporal_load((const h16x8*)(xin + (size_t)(row0 + ai * HALF + m * 16) * D + col0 + bj * HALF));
#pragma unroll
        for (int ai = 0; ai < 2; ++ai)
#pragma unroll
            for (int m = 0; m < 4; ++m) { const int r = row0 + ai * HALF + m * 16;
#pragma unroll
                for (int bj = 0; bj < 2; ++bj) { const int c = col0 + bj * HALF;
                    const f32x4 v0 = acc[ai][bj][m][0], v1 = acc[ai][bj][m][1];
                    h16x8 w;
#pragma unroll
                    for (int e = 0; e < 4; ++e) { w[e] = (h16)((float)xv[ai][m][bj][e] + g0[bj][e] * v0[e]); w[4 + e] = (h16)((float)xv[ai][m][bj][4 + e] + g1[bj][e] * v1[e]); }
                    *(h16x8*)(xout + (size_t)r * D + c) = w; } }
    }
};
}

__device__ __forceinline__ void conv_tile(const float* src, int ld, int nvalid, h16* dst, int k0, int n0, float* tile  ) {
    const int tid = threadIdx.x;
    float v[16];
#pragma unroll
    for (int i = 0; i < 16; ++i) { const int e = tid + i * 512, kk = e >> 6, nn = e & 63;
        v[i] = (n0 + nn < nvalid) ? __builtin_nontemporal_load(src + (size_t)(k0 + kk) * ld + n0 + nn) : 0.f; }
#pragma unroll
    for (int i = 0; i < 16; ++i) { const int e = tid + i * 512, kk = e >> 6, nn = e & 63; tile[kk * 65 + nn] = v[i]; }
    __syncthreads();
    { const int nn = tid >> 3, ks = (tid & 7) * 16; h16x8 w0, w1;
#pragma unroll
        for (int j = 0; j < 8; ++j) { w0[j] = (h16)tile[(ks + j) * 65 + nn]; w1[j] = (h16)tile[(ks + 8 + j) * 65 + nn]; }
        *(h16x8*)(dst + (size_t)(n0 + nn) * 2048 + k0 + ks) = w0; *(h16x8*)(dst + (size_t)(n0 + nn) * 2048 + k0 + ks + 8) = w1; }
    __syncthreads();
}

__device__ void conv_win(const Params& p, int l, float* ldsf, int t0, int tstride) {
    for (int t = t0; t < 16 * 112; t += tstride) { const int kt = t & 15, ntile = t >> 4;
        conv_tile(p.w_in + (size_t)l * D * INW, INW, INW, p.wT_in, kt * 128, ntile * 64, ldsf); }
}

__device__ void phase_prologue(const Params& p, float* ldsf) {
    const int tid = threadIdx.x;
    for (int t = blockIdx.x; t < 192 + 1024 + 1792 + 96; t += gridDim.x) {
        if (t >= 192 + 1024 + 1792) {
            const int o8 = (t - (192 + 1024 + 1792)) * 512 + tid;
            const int j0 = (o8 & 7) * 8, c = (o8 >> 3) & 63, hh = (o8 >> 9) % 12, m = ((o8 >> 9) / 12) & 1, ld = (o8 >> 9) / 24;
            const float* src = (m ? p.rw_a2 : p.rw_w2) + (size_t)ld * 64 * 768 + hh * 64 + c;
            h16x8 w;
#pragma unroll
            for (int e = 0; e < 8; ++e) w[e] = (h16)src[(size_t)(j0 + e) * 768];
            *(h16x8*)(p.rwT + (size_t)o8 * 8) = w;
        } else if (t < 192) {
            const int l = t / 96, cc = (t % 96) * 64;
            float* sc = ldsf;
            float* red = ldsf + 5 * 2048;
            for (int i = tid; i < 5 * 2048; i += 512) { const int cnd = i >> 11, k = i & 2047; const float v = cnd == 0 ? p.c_ctx[k] : p.c[(cnd - 1) * 2048 + k]; sc[i] = silu_f(v); }
            __syncthreads();
            const int col = cc + (tid & 63), kg = tid >> 6;
            float a0 = 0, a1 = 0, a2 = 0, a3 = 0, a4 = 0;
            const float* wp = p.w_mod + (size_t)l * D * 6144 + col;
#pragma unroll 32
            for (int k = kg; k < 2048; k += 8) { const float w = __builtin_nontemporal_load(wp + (size_t)k * 6144);
                a0 += sc[k] * w; a1 += sc[2048 + k] * w; a2 += sc[4096 + k] * w; a3 += sc[6144 + k] * w; a4 += sc[8192 + k] * w; }
            red[(kg * 5 + 0) * 64 + (tid & 63)] = a0; red[(kg * 5 + 1) * 64 + (tid & 63)] = a1; red[(kg * 5 + 2) * 64 + (tid & 63)] = a2;
            red[(kg * 5 + 3) * 64 + (tid & 63)] = a3; red[(kg * 5 + 4) * 64 + (tid & 63)] = a4;
            __syncthreads();
            if (tid < 320) { const int cnd = tid >> 6, cl = tid & 63; float s = p.b_mod[l * 6144 + cc + cl];
#pragma unroll
                for (int g = 0; g < 8; ++g) s += red[(g * 5 + cnd) * 64 + cl];
                p.mod[(size_t)(l * 5 + cnd) * 6144 + cc + cl] = s; }
            __syncthreads();
        } else if (t < 192 + 1024) {
            const int u = t - 192, l = u >> 9, kt = u & 15, ntile = (u >> 4) & 31;
            conv_tile(p.w_out + (size_t)l * D * D, D, D, p.wT_out + (size_t)l * D * D, kt * 128, ntile * 64, ldsf);
        } else {
            const int u = t - 192 - 1024, kt = u & 15, ntile = u >> 4;
            conv_tile(p.w_in, INW, INW, p.wT_in, kt * 128, ntile * 64, ldsf);
        }
    }
}

__device__ __forceinline__ void load_row_f32(const float* xr, int lane, f32x4 (&xv)[8]) {
#pragma unroll
    for (int j = 0; j < 8; ++j) xv[j] = __builtin_nontemporal_load((const f32x4*)(xr + (j * 64 + lane) * 4));
}
__device__ __forceinline__ void load_row_h16_nt(const h16* xr, int lane, f32x4 (&xv)[8]) {
#pragma unroll
    for (int j = 0; j < 8; ++j) { const h16x4 t = __builtin_nontemporal_load((const h16x4*)(xr + (j * 64 + lane) * 4)); xv[j] = (f32x4){(float)t[0], (float)t[1], (float)t[2], (float)t[3]}; }
}
__device__ __forceinline__ void load_row_h16(const h16* xr, int lane, f32x4 (&xv)[8]) {
#pragma unroll
    for (int j = 0; j < 8; ++j) { const h16x4 t = *(const h16x4*)(xr + (j * 64 + lane) * 4); xv[j] = (f32x4){(float)t[0], (float)t[1], (float)t[2], (float)t[3]}; }
}
__device__ void phase_prep(const Params& p, int l) {
    const int lane = threadIdx.x & 63, wid = threadIdx.x >> 6;
    const float* nw = p.norm_w + l * D;
    h16* x0h = (h16*)p.out;
    const h16* x1h = (const h16*)p.out + (size_t)NTOK * D;
    const int stride = gridDim.x * 8;
    int r = blockIdx.x * 8 + wid;
    f32x4 xv[8], xn[8];
    auto load = [&](int rr, f32x4 (&dst)[8]) {
        if (l == 0) load_row_f32(rr < NCTX ? p.x_prompt + (size_t)rr * D : p.x_sample + (size_t)(rr - NCTX) * D, lane, dst);
        else load_row_h16_nt(x1h + (size_t)rr * D, lane, dst);
    };
    if (r < NTOK) load(r, xv);
    while (r < NTOK) {
        const int rn = r + stride;
        if (rn < NTOK) load(rn, xn);
        const int cond = r < NCTX ? 0 : 1 + ((r - NCTX) >> 11);
        const float* mb = p.mod + (size_t)(l * 5 + cond) * 6144;
        float ss = 0.f;
        if (l == 0) {
#pragma unroll
            for (int j = 0; j < 8; ++j) { h16x4 o; o[0] = (h16)xv[j][0]; o[1] = (h16)xv[j][1]; o[2] = (h16)xv[j][2]; o[3] = (h16)xv[j][3]; *(h16x4*)(x0h + (size_t)r * D + (j * 64 + lane) * 4) = o; } }
#pragma unroll
        for (int j = 0; j < 8; ++j) ss += xv[j][0] * xv[j][0] + xv[j][1] * xv[j][1] + xv[j][2] * xv[j][2] + xv[j][3] * xv[j][3];
        ss = red64(ss);
        const float rs = rsqrtf(ss * (1.f / 2048.f) + 1e-6f);
#pragma unroll
        for (int j = 0; j < 8; ++j) { const int k = (j * 64 + lane) * 4;
            const f32x4 w = *(const f32x4*)(nw + k), sh = *(const f32x4*)(mb + k), scl = *(const f32x4*)(mb + 2048 + k);
            h16x4 o;
#pragma unroll
            for (int e = 0; e < 4; ++e) o[e] = (h16)(xv[j][e] * rs * w[e] * (1.f + scl[e]) + sh[e]);
            *(h16x4*)(p.hbuf + (size_t)r * D + k) = o; }
#pragma unroll
        for (int j = 0; j < 8; ++j) xv[j] = xn[j];
        r = rn;
    }
}

__device__ void phase_final(const Params& p) {
    const int lane = threadIdx.x & 63, wid = threadIdx.x >> 6;
    const h16* x2h = p.gla_of;
    const int stride = gridDim.x * 8;
    int r = blockIdx.x * 8 + wid;
    f32x4 xv[8], xn[8];
    if (r < NTOK) load_row_h16_nt(x2h + (size_t)r * D, lane, xv);
    while (r < NTOK) {
        const int rn = r + stride;
        if (rn < NTOK) load_row_h16_nt(x2h + (size_t)rn * D, lane, xn);
        float* yr = p.out + (size_t)r * D;
        float ss = 0.f;
#pragma unroll
        for (int j = 0; j < 8; ++j) ss += xv[j][0] * xv[j][0] + xv[j][1] * xv[j][1] + xv[j][2] * xv[j][2] + xv[j][3] * xv[j][3];
        ss = red64(ss);
        const float rs = rsqrtf(ss * (1.f / 2048.f) + 1e-6f);
#pragma unroll
        for (int j = 0; j < 8; ++j) { const int k = (j * 64 + lane) * 4; const f32x4 w = *(const f32x4*)(p.final_norm_w + k);
            __builtin_nontemporal_store(xv[j] * rs * w, (f32x4*)(yr + k)); }
#pragma unroll
        for (int j = 0; j < 8; ++j) xv[j] = xn[j];
        r = rn;
    }
}

__device__ __forceinline__ float silu_fast(float x) { return x * __builtin_amdgcn_rcpf(1.f + __expf(-x)); }
__device__ void phase_combine(const Params& p, int l) {
    const int lane = threadIdx.x & 63, wid = threadIdx.x >> 6;
    const bool lo = lane < 32;
    int cg[2], cr[2], hd[2];
    cg[0] = (lane >> 4) * 128 + (lane & 15) * 8; cg[1] = lo ? (4 + (lane >> 4)) * 128 + (lane & 15) * 8 : 0;
    hd[0] = lane >> 3; hd[1] = lo ? 8 + (lane >> 3) : 0;
    cr[0] = hd[0] * 64 + (lane & 7) * 8; cr[1] = hd[1] * 64 + (lane & 7) * 8;
    f32x4 wg[2][2], wr[2][2];
#pragma unroll
    for (int ps = 0; ps < 2; ++ps) { wg[ps][0] = *(const f32x4*)(p.gla_norm_w + l * 768 + cg[ps]); wg[ps][1] = *(const f32x4*)(p.gla_norm_w + l * 768 + cg[ps] + 4);
        wr[ps][0] = *(const f32x4*)(p.rw_gn_w + l * 768 + cr[ps]); wr[ps][1] = *(const f32x4*)(p.rw_gn_w + l * 768 + cr[ps] + 4); }
    for (int r = blockIdx.x * 8 + wid; r < NTOK; r += gridDim.x * 8) {
        const h16* zr = p.z + (size_t)r * INW; h16* orow = p.hbuf + (size_t)r * D;
        h16x8 ga[2], gb[2], gg[2], ra[2], rb[2], rv[2], rg[2]; float bs[2];
        const h16x8 zero8 = {0, 0, 0, 0, 0, 0, 0, 0};
#pragma unroll
        for (int ps = 0; ps < 2; ++ps) {
            if (ps == 0 || lo) {
                ga[ps] = __builtin_nontemporal_load((const h16x8*)(p.gla_of + (size_t)r * 768 + cg[ps])); gb[ps] = __builtin_nontemporal_load((const h16x8*)(p.gla_ob + (size_t)r * 768 + cg[ps])); gg[ps] = __builtin_nontemporal_load((const h16x8*)(zr + ZGG + cg[ps]));
                ra[ps] = __builtin_nontemporal_load((const h16x8*)(p.rw_yf + (size_t)r * 768 + cr[ps])); rb[ps] = __builtin_nontemporal_load((const h16x8*)(p.rw_yb + (size_t)r * 768 + cr[ps]));
                rv[ps] = __builtin_nontemporal_load((const h16x8*)(zr + ZRV + cr[ps])); rg[ps] = __builtin_nontemporal_load((const h16x8*)(zr + ZRG + cr[ps]));
                bs[ps] = p.bscal[(size_t)r * 12 + hd[ps]] + p.bscal[(size_t)(NTOK + r) * 12 + hd[ps]];
            } else { ga[ps] = zero8; gb[ps] = zero8; gg[ps] = zero8; ra[ps] = zero8; rb[ps] = zero8; rv[ps] = zero8; rg[ps] = zero8; bs[ps] = 0.f; }
        }
#pragma unroll
        for (int ps = 0; ps < 2; ++ps) {
            float o[8]; float ss = 0.f;
#pragma unroll
            for (int e = 0; e < 8; ++e) { o[e] = (float)ga[ps][e] + (float)gb[ps][e]; ss += o[e] * o[e]; }
            ss = red16(ss);
            const float rs = rsqrtf(ss * (1.f / 128.f) + 1e-6f);
            h16x8 ov;
#pragma unroll
            for (int e = 0; e < 8; ++e) ov[e] = (h16)(o[e] * rs * (e < 4 ? wg[ps][0][e & 3] : wg[ps][1][e & 3]) * silu_fast((float)gg[ps][e]));
            if (ps == 0 || lo) *(h16x8*)(orow + cg[ps]) = ov;
        }
#pragma unroll
        for (int ps = 0; ps < 2; ++ps) {
            float y[8]; float sm = 0.f;
#pragma unroll
            for (int e = 0; e < 8; ++e) { y[e] = (float)ra[ps][e] + (float)rb[ps][e]; sm += y[e]; }
            const float mu = red8(sm) * (1.f / 64.f);
            float vs = 0.f;
#pragma unroll
            for (int e = 0; e < 8; ++e) { y[e] -= mu; vs += y[e] * y[e]; }
            const float rs = rsqrtf(red8(vs) * (1.f / 64.f) + 64e-5f);
            h16x8 ov;
#pragma unroll
            for (int e = 0; e < 8; ++e) ov[e] = (h16)((y[e] * rs * (e < 4 ? wr[ps][0][e & 3] : wr[ps][1][e & 3]) + bs[ps] * (float)rv[ps][e]) * silu_fast((float)rg[ps][e]));
            if (ps == 0 || lo) *(h16x8*)(orow + 1280 + cr[ps]) = ov;
        }
    }
}

__device__ __forceinline__ f32x4 mfma16(const h16x8 a, const h16x8 b, const f32x4 c) { return __builtin_amdgcn_mfma_f32_16x16x32_f16(a, b, c, 0, 0, 0); }
__device__ __forceinline__ f32x4 mfma16b(const s16x8 a, const s16x8 b, const f32x4 c) { return __builtin_amdgcn_mfma_f32_16x16x32_bf16(a, b, c, 0, 0, 0); }

__device__ void cm_unit(const Params& p, int l, int r0, int g, unsigned char* lds) {
    int tid_ = threadIdx.x; asm volatile("" : "+v"(tid_));
    const int tid = tid_, lane = tid & 63, wid = tid >> 6, fr = lane & 15, fq = lane >> 4;
    h16* Ws = (h16*)lds;
    h16* VnT = (h16*)(lds + 128 * 136 * 2);
    const float* ws = p.cm_ws + (size_t)(l * 4 + g) * 128 * 128;
    for (int e = tid; e < 128 * 32; e += 512) { const int i = e >> 5, j4 = (e & 31) * 4; const f32x4 v = *(const f32x4*)(ws + i * 128 + j4);
        h16x4 o; o[0] = (h16)v[0]; o[1] = (h16)v[1]; o[2] = (h16)v[2]; o[3] = (h16)v[3]; *(h16x4*)(Ws + i * 136 + j4) = o; }
    for (int j = wid; j < 128; j += 8) {
        const h16x2 v = *(const h16x2*)(p.z + (size_t)(r0 + j) * INW + ZCV + g * 128 + 2 * lane);
        const float v0 = (float)v[0], v1 = (float)v[1];
        const float rs = rsqrtf(red64(v0 * v0 + v1 * v1) * (1.f / 128.f) + 1e-6f);
        const f32x2 w = *(const f32x2*)(p.cm_norm_w + l * 512 + g * 128 + 2 * lane);
        VnT[(2 * lane) * 136 + j] = (h16)(v0 * rs * w[0]); VnT[(2 * lane + 1) * 136 + j] = (h16)(v1 * rs * w[1]);
    }
    __syncthreads();
    f32x4 acc[8];
#pragma unroll
    for (int ct = 0; ct < 8; ++ct) acc[ct] = (f32x4){0.f, 0.f, 0.f, 0.f};
#pragma unroll
    for (int ks = 0; ks < 4; ++ks) {
        const h16x8 a = *(const h16x8*)(Ws + (16 * wid + fr) * 136 + ks * 32 + fq * 8);
#pragma unroll
        for (int ct = 0; ct < 8; ++ct) { const h16x8 b = *(const h16x8*)(VnT + (ct * 16 + fr) * 136 + ks * 32 + fq * 8); acc[ct] = mfma16(b, a, acc[ct]); }
    }
    const int i = 16 * wid + fr; const float bias = p.cm_bs[(l * 4 + g) * 128 + i];
    const h16* zr = p.z + (size_t)(r0 + i) * INW; h16* orow = p.hbuf + (size_t)(r0 + i) * D + 768 + g * 128;
#pragma unroll
    for (int ct = 0; ct < 8; ++ct) { const int c = ct * 16 + fq * 4;
        const h16x4 u = *(const h16x4*)(zr + ZCU + g * 128 + c), gt = *(const h16x4*)(zr + ZCG + g * 128 + c);
        h16x4 o;
#pragma unroll
        for (int jj = 0; jj < 4; ++jj) o[jj] = (h16)((float)u[jj] * (acc[ct][jj] + bias) * silu_fast((float)gt[jj]));
        *(h16x4*)(orow + c) = o; }
    __syncthreads();
}

__device__ void gla_unit(const Params& p, int l, bool lat, int b, int h, int d, unsigned char* lds) {
    int tid_ = threadIdx.x; asm volatile("" : "+v"(tid_));
    const int tid = tid_, lane = tid & 63, wid = tid >> 6, fr = lane & 15, fq = lane >> 4;
    const int L = lat ? 2048 : 256, nch = L / 64;
    const int rbase = lat ? NCTX + b * 2048 : b * 256;
    h16* Qraw = (h16*)(lds);
    h16* Att = Qraw;
    h16* Kraw = (h16*)(lds + 9216);
    unsigned short* Qb = (unsigned short*)(lds + 2 * 9216);
    unsigned short* Kb = (unsigned short*)(lds + 3 * 9216);
    h16* Qh = (h16*)(lds + 4 * 9216);
    h16* KeT = (h16*)(lds + 5 * 9216);
    h16* Vt = (h16*)(lds + 6 * 9216);
    h16* St = (h16*)(lds + 6 * 9216 + 18432);
    float* Bc = (float*)(lds + 6 * 9216 + 2 * 18432);
    h16* A2T = (h16*)(Bc + 4096);
    h16* Lor = A2T + 64 * 24;
    h16* laT = Lor + 64 * 24;
    float* Abias = (float*)(laT + 64 * 72);
    float* Ebl = Abias + 64;
    float* Rc = Ebl + 64;
    float* Rs = Rc + 1024;
    for (int e = tid; e < 1024; e += 512) { const int r = e >> 6, kk = e & 63; A2T[kk * 24 + r] = (h16)p.gla_a2[((size_t)(l * 2 + d) * 16 + r) * 384 + h * 64 + kk]; }
    if (tid < 64) Abias[tid] = p.gla_a_bias[(l * 2 + d) * 384 + h * 64 + tid];
    if (lat) for (int e = tid; e < 1024; e += 512) { const int pos = e >> 4, c = e & 15; const float inv = __expf(-(float)c * (9.210340371976184f / 16.f)); float s, co; __sincosf((float)pos * inv, &s, &co); Rc[e] = co; Rs[e] = s; }
    f32x4 S[4];
    const float* s0 = lat ? p.state_gla + ((((size_t)b * 2 + l) * 2 + d) * 6 + h) * 64 * 128 : nullptr;
#pragma unroll
    for (int kt = 0; kt < 4; ++kt)
#pragma unroll
        for (int jj = 0; jj < 4; ++jj) S[kt][jj] = lat ? s0[(kt * 16 + fq * 4 + jj) * 128 + 16 * wid + fr] : 0.f;
    h16* obuf = d == 0 ? p.gla_of : p.gla_ob;
    const int prow = tid >> 3, pseg = tid & 7;
    h16x8 pq, pk, pv0, pv1, plo;
    auto tokof = [&](int n, int i) -> int { return d == 0 ? n * 64 + i : L - 64 * (n + 1) + 63 - i; };
    auto prefetch = [&](int n) {
        const h16* zr = p.z + (size_t)(rbase + tokof(n, prow)) * INW;
        pq = *(const h16x8*)(zr + ZQ + h * 64 + pseg * 8); pk = *(const h16x8*)(zr + ZK + h * 64 + pseg * 8);
        pv0 = *(const h16x8*)(zr + ZV + h * 128 + pseg * 16); pv1 = *(const h16x8*)(zr + ZV + h * 128 + pseg * 16 + 8);
        if (fq < 2) plo = *(const h16x8*)(p.z + (size_t)(rbase + tokof(n, (wid >> 1) * 16 + fr)) * INW + ZLORA + fq * 8);
    };
    prefetch(0);
    for (int n = 0; n < nch; ++n) {
        __syncthreads();
        *(h16x8*)(Qraw + prow * 72 + pseg * 8) = pq; *(h16x8*)(Kraw + prow * 72 + pseg * 8) = pk;
#pragma unroll
        for (int j = 0; j < 8; ++j) { Vt[(pseg * 16 + j) * 72 + prow] = pv0[j]; Vt[(pseg * 16 + 8 + j) * 72 + prow] = pv1[j]; }
#pragma unroll
        for (int kt = 0; kt < 4; ++kt) { h16x4 sv; sv[0] = (h16)S[kt][0]; sv[1] = (h16)S[kt][1]; sv[2] = (h16)S[kt][2]; sv[3] = (h16)S[kt][3];
            *(h16x4*)(St + (16 * wid + fr) * 72 + kt * 16 + fq * 4) = sv; }
        { const int it = wid >> 1; const h16x8 zero8 = {0, 0, 0, 0, 0, 0, 0, 0};
            const h16x8 lf = (fq < 2) ? plo : zero8;
#pragma unroll
            for (int t2 = 0; t2 < 2; ++t2) { const int kt = (wid & 1) * 2 + t2;
                const h16x8 af = (fq < 2) ? *(const h16x8*)(A2T + (kt * 16 + fr) * 24 + fq * 8) : zero8;
                const f32x4 zz = mfma16(af, lf, (f32x4){0.f, 0.f, 0.f, 0.f});
                const f32x4 bi = *(const f32x4*)(Abias + kt * 16 + fq * 4);
#pragma unroll
                for (int jj = 0; jj < 4; ++jj) { const float z1 = zz[jj] + bi[jj];
                    const float ls = fminf(z1, 0.f) - __logf(1.f + __expf(-fabsf(z1)));
                    laT[(kt * 16 + fq * 4 + jj) * 72 + it * 16 + fr] = (h16)fmaxf(ls * (1.f / 16.f), -1.f); } } }
        __syncthreads();
        if (n + 1 < nch) prefetch(n + 1);
        { const int it = wid >> 1; h16x8 lt[2];
#pragma unroll
            for (int kb = 0; kb < 2; ++kb)
#pragma unroll
                for (int e = 0; e < 8; ++e) lt[kb][e] = (kb * 32 + fq * 8 + e <= it * 16 + fr) ? (h16)1.f : (h16)0.f;
#pragma unroll
            for (int t2 = 0; t2 < 2; ++t2) { const int kt = (wid & 1) * 2 + t2; f32x4 bacc = (f32x4){0.f, 0.f, 0.f, 0.f};
#pragma unroll
                for (int kb = 0; kb < 2; ++kb) { const h16x8 lf = *(const h16x8*)(laT + (kt * 16 + fr) * 72 + kb * 32 + fq * 8); bacc = mfma16(lf, lt[kb], bacc); }
                *(f32x4*)(Bc + (it * 16 + fr) * 64 + kt * 16 + fq * 4) = bacc;
                if (it == 3 && fr == 15) { f32x4 eb; eb[0] = __expf(bacc[0]); eb[1] = __expf(bacc[1]); eb[2] = __expf(bacc[2]); eb[3] = __expf(bacc[3]); *(f32x4*)(Ebl + kt * 16 + fq * 4) = eb; } } }
        __syncthreads();
        { const int i = prow, a = pseg, k0 = a * 8;
            const h16x8 qo = *(const h16x8*)(Qraw + i * 72 + k0), ko = *(const h16x8*)(Kraw + i * 72 + k0);
            float qv[8], kv[8];
#pragma unroll
            for (int j = 0; j < 8; ++j) { qv[j] = (float)qo[j] * 0.125f; kv[j] = (float)ko[j]; }
            if (lat) {
                const h16x8 qp = *(const h16x8*)(Qraw + i * 72 + (k0 ^ 16)), kp = *(const h16x8*)(Kraw + i * 72 + (k0 ^ 16));
                const int tok = tokof(n, i); const int pos = (a < 4) ? (tok >> 6) : (tok & 63); const bool first = (a & 2) == 0; const int cb = (a & 1) * 8;
#pragma unroll
                for (int j = 0; j < 8; ++j) { const float co = Rc[pos * 16 + cb + j], si = Rs[pos * 16 + cb + j]; const float qpp = (float)qp[j] * 0.125f, kpp = (float)kp[j];
                    qv[j] = first ? (qv[j] * co - qpp * si) : (qpp * si + qv[j] * co);
                    kv[j] = first ? (kv[j] * co - kpp * si) : (kpp * si + kv[j] * co); }
            }
            s16x8 qb, kb; h16x8 qh;
#pragma unroll
            for (int j = 0; j < 8; ++j) { const float ee = __expf(Bc[i * 64 + k0 + j]);
                const float qt = qv[j] * ee, kt = kv[j] * __builtin_amdgcn_rcpf(ee), ke = kt * Ebl[k0 + j];
                qb[j] = (short)f2bf(qt); kb[j] = (short)f2bf(kt); qh[j] = (h16)qt; KeT[(k0 + j) * 72 + i] = (h16)ke; }
            *(s16x8*)(Qb + i * 72 + k0) = qb; *(s16x8*)(Kb + i * 72 + k0) = kb; *(h16x8*)(Qh + i * 72 + k0) = qh;
        }
        __syncthreads();
        f32x4 O[4];
#pragma unroll
        for (int it = 0; it < 4; ++it) O[it] = (f32x4){0.f, 0.f, 0.f, 0.f};
#pragma unroll
        for (int ks = 0; ks < 2; ++ks) { const h16x8 sb = *(const h16x8*)(St + (16 * wid + fr) * 72 + ks * 32 + fq * 8);
#pragma unroll
            for (int it = 0; it < 4; ++it) { const h16x8 qa = *(const h16x8*)(Qh + (it * 16 + fr) * 72 + ks * 32 + fq * 8); O[it] = mfma16(sb, qa, O[it]); } }
        { const int it = wid >> 1;
#pragma unroll
            for (int t2 = 0; t2 < 2; ++t2) { const int jt = (wid & 1) * 2 + t2; f32x4 at = (f32x4){0.f, 0.f, 0.f, 0.f};
                if (jt <= it) {
#pragma unroll
                    for (int ks = 0; ks < 2; ++ks) { const s16x8 qa = *(const s16x8*)(Qb + (it * 16 + fr) * 72 + ks * 32 + fq * 8), kb = *(const s16x8*)(Kb + (jt * 16 + fr) * 72 + ks * 32 + fq * 8);
                        at = mfma16b(kb, qa, at); } }
                h16x4 av;
#pragma unroll
                for (int jj = 0; jj < 4; ++jj) { const int i = it * 16 + fr, j = jt * 16 + fq * 4 + jj; av[jj] = (h16)((j <= i) ? at[jj] : 0.f); }
                *(h16x4*)(Att + (it * 16 + fr) * 72 + jt * 16 + fq * 4) = av; } }
        __syncthreads();
        { h16x8 vb[2];
#pragma unroll
            for (int ks = 0; ks < 2; ++ks) vb[ks] = *(const h16x8*)(Vt + (16 * wid + fr) * 72 + ks * 32 + fq * 8);
#pragma unroll
            for (int it = 0; it < 4; ++it)
#pragma unroll
                for (int ks = 0; ks < 2; ++ks) { const h16x8 aa = *(const h16x8*)(Att + (it * 16 + fr) * 72 + ks * 32 + fq * 8); O[it] = mfma16(vb[ks], aa, O[it]); }
#pragma unroll
            for (int kt = 0; kt < 4; ++kt) { const f32x4 bl = *(const f32x4*)(Ebl + kt * 16 + fq * 4);
                S[kt] = S[kt] * bl;
#pragma unroll
                for (int ks = 0; ks < 2; ++ks) { const h16x8 ka = *(const h16x8*)(KeT + (kt * 16 + fr) * 72 + ks * 32 + fq * 8); S[kt] = mfma16(ka, vb[ks], S[kt]); } }
        }
#pragma unroll
        for (int it = 0; it < 4; ++it) { const int tok = tokof(n, it * 16 + fr); h16x4 ov; ov[0] = (h16)O[it][0]; ov[1] = (h16)O[it][1]; ov[2] = (h16)O[it][2]; ov[3] = (h16)O[it][3];
            *(h16x4*)(obuf + (size_t)(rbase + tok) * 768 + h * 128 + 16 * wid + fq * 4) = ov; }
    }
    if (!lat) { float* so = p.out + OUT_SG + ((((size_t)b * 2 + l) * 2 + d) * 6 + h) * 64 * 128;
#pragma unroll
        for (int kt = 0; kt < 4; ++kt)
#pragma unroll
            for (int jj = 0; jj < 4; ++jj) __builtin_nontemporal_store(S[kt][jj], so + (kt * 16 + fq * 4 + jj) * 128 + 16 * wid + fr); }
    __syncthreads();
}

__device__ __forceinline__ h16x4 cvt4(const f32x4 a) { h16x4 r; r[0] = (h16)a[0]; r[1] = (h16)a[1]; r[2] = (h16)a[2]; r[3] = (h16)a[3]; return r; }
__device__ __forceinline__ f32x4 mm16(const h16x4 second, const h16x4 first, const f32x4 acc) {
    h16x8 f8, s8;
#pragma unroll
    for (int e = 0; e < 4; ++e) { f8[e] = first[e]; s8[e] = second[e]; f8[4 + e] = (h16)0.f; s8[4 + e] = (h16)0.f; }
    return __builtin_amdgcn_mfma_f32_16x16x32_f16(f8, s8, acc, 0, 0, 0); }
__device__ __forceinline__ f32x4 mm32(const h16x8 second, const h16x8 first, const f32x4 acc) { return __builtin_amdgcn_mfma_f32_16x16x32_f16(first, second, acc, 0, 0, 0); }
__device__ void rwkv_unit(const Params& p, int l, bool lat, int b, int h, int d, unsigned char* lds) {
    constexpr int T = 32;
    int tid_ = threadIdx.x; asm volatile("" : "+v"(tid_));
    const int tid = tid_, lane = tid & 63, wid = __builtin_amdgcn_readfirstlane(tid >> 6);
    const int L = lat ? 2048 : 256, nblk = L / T;
    const int rbase = lat ? NCTX + b * 2048 : b * 256;
    float* Wb = (float*)lds;
    h16* Hb = (h16*)(lds + 16384);
    h16* FR = (h16*)(lds + 57344);
    h16* OPa = (h16*)(lds + 75776);
    h16* OPt = (h16*)(lds + 75776 + 6 * T * 72 * 2);
    float* Gf = (float*)(lds + 75776 + 6 * T * 72 * 2 + 3 * 2 * 64 * 20 * 2);
    h16* ybuf = d == 0 ? p.rw_yf : p.rw_yb;
    float* bsc = p.bscal + (size_t)d * NTOK * 12;
    auto tokof = [&](int s) -> int { return d == 0 ? s : L - 1 - s; };
    const bool chain = wid < 4;
    const int fr = lane & 15, fq = lane >> 4;
    const int v0 = 16 * (wid & 3);
    f32x4 S[4];
    const int pw = wid & 3, ts = fr & 7, chalf = fr >> 3;
    if (chain) {
        if (lat) { const float* s0 = p.state_rwkv + ((((size_t)b * 2 + l) * 2 + d) * 12 + h) * 4096;
#pragma unroll
            for (int kt = 0; kt < 4; ++kt) S[kt] = *(const f32x4*)(s0 + (v0 + fr) * 64 + kt * 16 + fq * 4);
        } else {
#pragma unroll
            for (int kt = 0; kt < 4; ++kt) S[kt] = (f32x4){0.f, 0.f, 0.f, 0.f}; }
    } else {
    }
    h16x8 pwl[2], pal[2]; h16x4 prv[2], pkv[2], pvv[2];
    auto pf_load = [&](int nb) {
        const h16* zr = p.z + (size_t)(rbase + tokof(nb * T + pw * 8 + ts)) * INW;
#pragma unroll
        for (int kb = 0; kb < 2; ++kb) { pwl[kb] = *(const h16x8*)(zr + ZWL + kb * 32 + fq * 8); pal[kb] = *(const h16x8*)(zr + ZAL + kb * 32 + fq * 8); }
#pragma unroll
        for (int u = 0; u < 2; ++u) { const int c = h * 64 + (2 * chalf + u) * 16 + fq * 4;
            prv[u] = *(const h16x4*)(zr + ZRR + c); pkv[u] = *(const h16x4*)(zr + ZRK + c); pvv[u] = *(const h16x4*)(zr + ZRV + c); }
    };
    auto prepare = [&](int nb, bool active) {
        h16x8 twf[2], alf[2]; h16x4 rv4[2], kv4[2], vv4[2];
        const int i = pw * 8 + ts; int tok = 0;
        f32x4 dwa[4], daa[4];
        if (active) {
            tok = tokof(nb * T + i);
            h16x8 w2f[4][2], a2f[4][2];
#pragma unroll
            for (int ct = 0; ct < 4; ++ct)
#pragma unroll
                for (int kb = 0; kb < 2; ++kb) { w2f[ct][kb] = *(const h16x8*)(FR + (ct * 16 + fr) * 72 + kb * 32 + fq * 8); a2f[ct][kb] = *(const h16x8*)(FR + (64 + ct * 16 + fr) * 72 + kb * 32 + fq * 8); }
#pragma unroll
            for (int kb = 0; kb < 2; ++kb) { alf[kb] = pal[kb];
                typedef unsigned u32x4_t __attribute__((ext_vector_type(4)));
                typedef unsigned u32x2_t __attribute__((ext_vector_type(2)));
                const u32x4_t raw = __builtin_bit_cast(u32x4_t, pwl[kb]);
                u32x2_t sel; sel[0] = chalf ? raw[2] : raw[0]; sel[1] = chalf ? raw[3] : raw[1];
                const h16x4 src = __builtin_bit_cast(h16x4, sel);
                h16x4 mine;
#pragma unroll
                for (int e = 0; e < 4; ++e) { const float x = (float)src[e]; const float e2 = __expf(2.f * x); mine[e] = (h16)(1.f - 2.f * __builtin_amdgcn_rcpf(e2 + 1.f)); }
                const u32x2_t mu = __builtin_bit_cast(u32x2_t, mine);
                u32x2_t ou; ou[0] = (unsigned)__builtin_amdgcn_update_dpp(0, (int)mu[0], 0x128, 0xF, 0xF, true); ou[1] = (unsigned)__builtin_amdgcn_update_dpp(0, (int)mu[1], 0x128, 0xF, 0xF, true);
                u32x4_t res; res[0] = chalf ? ou[0] : mu[0]; res[1] = chalf ? ou[1] : mu[1]; res[2] = chalf ? mu[0] : ou[0]; res[3] = chalf ? mu[1] : ou[1];
                twf[kb] = __builtin_bit_cast(h16x8, res); }
#pragma unroll
            for (int u = 0; u < 2; ++u) { rv4[u] = prv[u]; kv4[u] = pkv[u]; vv4[u] = pvv[u]; }
            if (nb + 1 < nblk) pf_load(nb + 1);
#pragma unroll
            for (int ct = 0; ct < 4; ++ct) { dwa[ct] = (f32x4){0.f, 0.f, 0.f, 0.f}; daa[ct] = dwa[ct];
#pragma unroll
                for (int kb = 0; kb < 2; ++kb) { dwa[ct] = mm32(twf[kb], w2f[ct][kb], dwa[ct]); daa[ct] = mm32(alf[kb], a2f[ct][kb], daa[ct]); } }
        }
        __syncthreads();
        if (!active) return;
        float* wbw = Wb + (nb & 1) * T * 64; h16* hbw = Hb + (nb & 1) * 5 * T * 64;
        float cw0[8], ca0[8], ckk[8], cka[8], crk[8];
#pragma unroll
        for (int u = 0; u < 2; ++u) { const int hc = h * 64 + (2 * chalf + u) * 16 + fq * 4;
            const f32x4 t0 = *(const f32x4*)(p.rw_w0 + (l * 2 + d) * 768 + hc), t1 = *(const f32x4*)(p.rw_a0 + (l * 2 + d) * 768 + hc),
                        t2 = *(const f32x4*)(p.rw_kk + l * 768 + hc), t3 = *(const f32x4*)(p.rw_ka + l * 768 + hc), t4 = *(const f32x4*)(p.rw_rk + l * 768 + hc);
#pragma unroll
            for (int jj = 0; jj < 4; ++jj) { cw0[u * 4 + jj] = t0[jj]; ca0[u * 4 + jj] = t1[jj]; ckk[u * 4 + jj] = t2[jj]; cka[u * 4 + jj] = t3[jj]; crk[u * 4 + jj] = t4[jj]; } }
        float dec[8], kd[8], kkv[8], icv[8], rr[8];
        float nrm = 0.f, bon = 0.f;
#pragma unroll
        for (int u = 0; u < 2; ++u) {
            const f32x4 dwsel = chalf ? dwa[2 + u] : dwa[u], dasel = chalf ? daa[2 + u] : daa[u];
#pragma unroll
            for (int jj = 0; jj < 4; ++jj) { const int q = u * 4 + jj;
                const float aw = cw0[q] + dwsel[jj], aa = ca0[q] + dasel[jj];
                dec[q] = __expf(-0.60653065971f * __builtin_amdgcn_rcpf(1.f + __expf(-aw)));
                icv[q] = __builtin_amdgcn_rcpf(1.f + __expf(-aa));
                const float kraw = (float)kv4[u][jj]; rr[q] = (float)rv4[u][jj];
                kkv[q] = kraw * ckk[q]; nrm += kkv[q] * kkv[q];
                kd[q] = kraw * (1.f + (icv[q] - 1.f) * cka[q]);
                bon += rr[q] * kd[q] * crk[q]; } }
        nrm += dppf<0x128>(nrm); bon += dppf<0x128>(bon);
        nrm += __shfl_xor(nrm, 16); bon += __shfl_xor(bon, 16);
        nrm += __shfl_xor(nrm, 32); bon += __shfl_xor(bon, 32);
        const float rn = rsqrtf(fmaxf(nrm, 1e-24f));
#pragma unroll
        for (int u = 0; u < 2; ++u) { const int c = (2 * chalf + u) * 16 + fq * 4; const int o = i * 64 + c;
            f32x4 wq; h16x4 kq, aq, bq, rq, vq;
#pragma unroll
            for (int jj = 0; jj < 4; ++jj) { const int q = u * 4 + jj; const float kk = kkv[q] * rn;
                wq[jj] = dec[q]; kq[jj] = (h16)kd[q]; aq[jj] = (h16)(-kk); bq[jj] = (h16)(kk * icv[q]); }
            rq = rv4[u]; vq = vv4[u];
            *(f32x4*)(wbw + o) = wq; *(h16x4*)(hbw + 0 * T * 64 + o) = kq; *(h16x4*)(hbw + 1 * T * 64 + o) = aq;
            *(h16x4*)(hbw + 2 * T * 64 + o) = bq; *(h16x4*)(hbw + 3 * T * 64 + o) = rq; *(h16x4*)(hbw + 4 * T * 64 + o) = vq; }
        if (lane == ts) bsc[(size_t)(rbase + tok) * 12 + h] = bon;
    };
    __syncthreads();
    for (int e = tid; e < 2 * 64 * 8; e += 512) { const int m = e >> 9, c = (e >> 3) & 63, j8 = (e & 7) * 8;
        *(h16x8*)(FR + (m * 64 + c) * 72 + j8) = *(const h16x8*)(p.rwT + ((size_t)((l * 2 + d) * 2 + m) * 12 + h) * 4096 + c * 64 + j8); }
    __syncthreads();
    if (!chain) { pf_load(0); prepare(0, true); } else __syncthreads();
    __syncthreads();
    for (int nb = 0; nb < nblk; ++nb) {
        if (chain) {
            { const float* bw = Wb + (nb & 1) * T * 64; const h16* hb = Hb + (nb & 1) * 5 * T * 64;
                const int gl = tid & 255, c2 = gl & 31, q = (gl >> 5) & 1, qt = gl >> 6, c = 2 * c2;
                f32x2 G[16]; { f32x2 run = (f32x2){1.f, 1.f};
#pragma unroll
                    for (int t = 0; t < 16; ++t) { run = run * *(const f32x2*)(bw + (16 * q + t) * 64 + c); G[t] = run; } }
                const f32x2 gref = G[7], gend = G[15];
                f32x2 iref; iref[0] = __builtin_amdgcn_rcpf(gref[0]); iref[1] = __builtin_amdgcn_rcpf(gref[1]);
#pragma unroll
                for (int t = 0; t < 16; ++t) {
                    if ((t >> 2) == qt) {
                        const int i = 16 * q + t; const f32x2 g = G[t], gm1 = t ? G[t - 1] : (f32x2){1.f, 1.f};
                        f32x2 ig; ig[0] = __builtin_amdgcn_rcpf(g[0]); ig[1] = __builtin_amdgcn_rcpf(g[1]);
                        const h16x2 k2 = *(const h16x2*)(hb + 0 * T * 64 + i * 64 + c), a2 = *(const h16x2*)(hb + 1 * T * 64 + i * 64 + c), b2 = *(const h16x2*)(hb + 2 * T * 64 + i * 64 + c),
                                    r2 = *(const h16x2*)(hb + 3 * T * 64 + i * 64 + c), v2 = *(const h16x2*)(hb + 4 * T * 64 + i * 64 + c);
                        const f32x2 kv_ = (f32x2){(float)k2[0], (float)k2[1]}, av = (f32x2){(float)a2[0], (float)a2[1]}, bv = (f32x2){(float)b2[0], (float)b2[1]}, rv = (f32x2){(float)r2[0], (float)r2[1]};
                        const f32x2 at = av * gm1, rt = rv * g, bs = bv * ig, ks_ = kv_ * ig;
                        const f32x2 ah_ = at * iref, rh_ = rt * iref, bh_ = bs * gref, kh_ = ks_ * gref, bb_ = bs * gend, kb_ = ks_ * gend;
                        h16x2 o;
                        o[0] = (h16)at[0]; o[1] = (h16)at[1]; *(h16x2*)(OPa + (0 * T + i) * 72 + c) = o;
                        o[0] = (h16)rt[0]; o[1] = (h16)rt[1]; *(h16x2*)(OPa + (1 * T + i) * 72 + c) = o;
                        o[0] = (h16)ah_[0]; o[1] = (h16)ah_[1]; *(h16x2*)(OPa + (2 * T + i) * 72 + c) = o;
                        o[0] = (h16)rh_[0]; o[1] = (h16)rh_[1]; *(h16x2*)(OPa + (3 * T + i) * 72 + c) = o;
                        o[0] = (h16)bh_[0]; o[1] = (h16)bh_[1]; *(h16x2*)(OPa + (4 * T + i) * 72 + c) = o;
                        o[0] = (h16)kh_[0]; o[1] = (h16)kh_[1]; *(h16x2*)(OPa + (5 * T + i) * 72 + c) = o;
                        OPt[((0 * 2 + q) * 64 + c) * 20 + t] = (h16)bb_[0]; OPt[((0 * 2 + q) * 64 + c + 1) * 20 + t] = (h16)bb_[1];
                        OPt[((1 * 2 + q) * 64 + c) * 20 + t] = (h16)kb_[0]; OPt[((1 * 2 + q) * 64 + c + 1) * 20 + t] = (h16)kb_[1];
                        OPt[((2 * 2 + q) * 64 + c) * 20 + t] = v2[0]; OPt[((2 * 2 + q) * 64 + c + 1) * 20 + t] = v2[1];
                    } }
                if (qt == 0) *(f32x2*)(Gf + q * 64 + c) = gend; }
            __syncthreads();
#pragma unroll
            for (int q = 0; q < 2; ++q) {
                const int row = 16 * q + fr;
                h16x8 ah[2], bh[2], kh[2], rh[2];
#pragma unroll
                for (int kb = 0; kb < 2; ++kb) { ah[kb] = *(const h16x8*)(OPa + (2 * T + row) * 72 + kb * 32 + fq * 8); rh[kb] = *(const h16x8*)(OPa + (3 * T + row) * 72 + kb * 32 + fq * 8);
                    bh[kb] = *(const h16x8*)(OPa + (4 * T + row) * 72 + kb * 32 + fq * 8); kh[kb] = *(const h16x8*)(OPa + (5 * T + row) * 72 + kb * 32 + fq * 8); }
                const f32x4 zero4 = (f32x4){0.f, 0.f, 0.f, 0.f};
                f32x4 NT = zero4, N = zero4, MakT = zero4, NabT = zero4, NakT = zero4;
#pragma unroll
                for (int kb = 0; kb < 2; ++kb) { NT = mm32(ah[kb], bh[kb], NT); N = mm32(bh[kb], ah[kb], N); MakT = mm32(ah[kb], kh[kb], MakT);
                    NabT = mm32(rh[kb], bh[kb], NabT); NakT = mm32(rh[kb], kh[kb], NakT); }
                f32x4 TT;
#pragma unroll
                for (int jj = 0; jj < 4; ++jj) { const int n = fq * 4 + jj, m = fr;
                    NT[jj] = (n < m) ? NT[jj] : 0.f; N[jj] = (m < n) ? N[jj] : 0.f; MakT[jj] = (n < m) ? MakT[jj] : 0.f;
                    NabT[jj] = (n <= m) ? NabT[jj] : 0.f; NakT[jj] = (n <= m) ? NakT[jj] : 0.f;
                    TT[jj] = NT[jj] + ((n == m) ? 1.f : 0.f); }
                { h16x4 pn = cvt4(N), pt = cvt4(NT);
                    f32x4 N2 = mm16(pn, pt, zero4), N2T = mm16(pt, pn, zero4);
                    TT = mm16(cvt4(TT), cvt4(N2), TT);
                    pn = cvt4(N2); pt = cvt4(N2T);
                    f32x4 N4 = mm16(pn, pt, zero4), N4T = mm16(pt, pn, zero4);
                    TT = mm16(cvt4(TT), cvt4(N4), TT);
                    const f32x4 N8 = mm16(cvt4(N4), cvt4(N4T), zero4);
                    TT = mm16(cvt4(TT), cvt4(N8), TT); }
                h16x8 sf[2];
#pragma unroll
                for (int kb = 0; kb < 2; ++kb)
#pragma unroll
                    for (int e = 0; e < 4; ++e) { sf[kb][e] = (h16)S[2 * kb][e]; sf[kb][4 + e] = (h16)S[2 * kb + 1][e]; }
                h16x8 atp[2], rtp[2];
#pragma unroll
                for (int kb = 0; kb < 2; ++kb) { const h16x4 a0 = *(const h16x4*)(OPa + (0 * T + row) * 72 + (2 * kb) * 16 + fq * 4), a1 = *(const h16x4*)(OPa + (0 * T + row) * 72 + (2 * kb + 1) * 16 + fq * 4);
                    const h16x4 r0 = *(const h16x4*)(OPa + (1 * T + row) * 72 + (2 * kb) * 16 + fq * 4), r1 = *(const h16x4*)(OPa + (1 * T + row) * 72 + (2 * kb + 1) * 16 + fq * 4);
#pragma unroll
                    for (int e = 0; e < 4; ++e) { atp[kb][e] = a0[e]; atp[kb][4 + e] = a1[e]; rtp[kb][e] = r0[e]; rtp[kb][4 + e] = r1[e]; } }
                const h16x4 vt4 = *(const h16x4*)(OPt + ((2 * 2 + q) * 64 + v0 + fr) * 20 + fq * 4);
                f32x4 X = zero4, Y = zero4;
#pragma unroll
                for (int kb = 0; kb < 2; ++kb) { X = mm32(sf[kb], atp[kb], X); Y = mm32(sf[kb], rtp[kb], Y); }
                X = mm16(vt4, cvt4(MakT), X);
                const f32x4 SA = mm16(cvt4(X), cvt4(TT), zero4);
                const h16x4 sa4 = cvt4(SA);
                Y = mm16(sa4, cvt4(NabT), Y);
                Y = mm16(vt4, cvt4(NakT), Y);
#pragma unroll
                for (int kt = 0; kt < 4; ++kt) { const f32x4 g = *(const f32x4*)(Gf + q * 64 + kt * 16 + fq * 4);
                    const h16x4 bb = *(const h16x4*)(OPt + ((0 * 2 + q) * 64 + kt * 16 + fr) * 20 + fq * 4), kb4 = *(const h16x4*)(OPt + ((1 * 2 + q) * 64 + kt * 16 + fr) * 20 + fq * 4);
                    f32x4 acc = S[kt] * g; acc = mm16(sa4, bb, acc); S[kt] = mm16(vt4, kb4, acc); }
#pragma unroll
                for (int jj = 0; jj < 4; ++jj) { const int tok = tokof(nb * T + 16 * q + fq * 4 + jj);
                    ybuf[(size_t)(rbase + tok) * 768 + h * 64 + v0 + fr] = (h16)Y[jj]; }
            }
        } else {
            prepare(nb + 1, nb + 1 < nblk);
        }
        __syncthreads();
    }
    if (chain && !lat) { float* so = p.out + OUT_SR + ((((size_t)b * 2 + l) * 2 + d) * 12 + h) * 4096;
#pragma unroll
        for (int kt = 0; kt < 4; ++kt) __builtin_nontemporal_store(S[kt], (f32x4*)(so + (v0 + fr) * 64 + kt * 16 + fq * 4)); }
    __syncthreads();
}

constexpr int NI_RWL = 96, NI_GLL = 48, NI_RWC = 768, NI_GLC = 384, NI_CM = 512, NI_TOTAL = NI_RWL + NI_GLL + NI_RWC + NI_GLC + NI_CM;

__device__ void phase_mixers(const Params& p, int l, unsigned char* lds, int cidx) {
    volatile int& s_item = *(volatile int*)(lds + 147440);
    for (;;) {
        if (threadIdx.x == 0) s_item = (int)atomicAdd(p.ctr + cidx, 1u);
        __syncthreads();
        int it = s_item;
        if (it >= NI_TOTAL) break;
        { const int ty = it < NI_RWL ? 1 : it < NI_RWL + NI_GLL ? 2 : it < NI_RWL + NI_GLL + NI_RWC ? 4 : it < NI_RWL + NI_GLL + NI_RWC + NI_GLC ? 8 : 16; if (!(p.sub & ty)) { __syncthreads(); continue; } }
#ifndef NO_RWKV
        if (it < NI_RWL) { rwkv_unit(p, l, true, it / 24, (it % 24) >> 1, it & 1, lds); continue; }
#endif
        it -= NI_RWL;
#ifndef NO_GLA
        if (it < NI_GLL) { gla_unit(p, l, true, it / 12, (it % 12) >> 1, it & 1, lds); continue; }
#endif
        it -= NI_GLL;
#ifndef NO_RWKV
        if (it < NI_RWC) { rwkv_unit(p, l, false, it / 24, (it % 24) >> 1, it & 1, lds); continue; }
#endif
        it -= NI_RWC;
#ifndef NO_GLA
        if (it < NI_GLC) { gla_unit(p, l, false, it / 12, (it % 12) >> 1, it & 1, lds); continue; }
#endif
        it -= NI_GLC;
#ifndef NO_CM
        cm_unit(p, l, (it >> 2) * 128, it & 3, lds);
#endif
    }
}

constexpr int NPHASE = 12;
template <int L> __device__ __forceinline__ void run_gemm1(const Params& p, unsigned char* lds) {
    pg8::Gemm g{p.hbuf, p.wT_in, NTOK, INWP, D}; pg8::StaticOrder S; S.init(NTOK, INWP, gridDim.x, blockIdx.x, 8); pg8::EpiZ E{p.z};
    pg8::gemm_phase((LAS unsigned char*)lds, g, S, E);
}
template <int L> __device__ __forceinline__ void run_gemm2(const Params& p, unsigned char* lds) {
    pg8::Gemm g{p.hbuf, p.wT_out + (size_t)L * D * D, NTOK, D, D}; pg8::StaticOrder S; S.init(NTOK, D, gridDim.x, blockIdx.x);
    h16* slotA = (h16*)p.out; h16* slotB = (h16*)p.out + (size_t)NTOK * D;
    pg8::EpiRes E{L == 0 ? slotA : slotB, L == 0 ? slotB : p.gla_of, p.mod + (size_t)L * 5 * 6144 + 4096};
    pg8::gemm_phase((LAS unsigned char*)lds, g, S, E);
}
#define RUN_PHASE(K, BODY) if (p.ph_lo <= (K) && (K) < p.ph_hi) { BODY; if ((K) + 1 < p.ph_hi) xcd_barrier(xb); }
__global__ void __launch_bounds__(512, 2) mega(Params p) {
    extern __shared__ __attribute__((aligned(16))) unsigned char lds[];
    cg::grid_group grid = cg::this_grid();
    uint4& xb_words = *(uint4*)(lds + 147424);
    if (threadIdx.x == 0) xb_words = make_uint4(0u, 0u, 0u, 0u);
    __syncthreads();
    XcdBarrier xb; xb.bar = p.bar; xb.x = 0; xb.st = (volatile LAS unsigned*)&xb_words;
    if (p.ph_hi - p.ph_lo > 1) xb = xcd_barrier_post(p.bar, (volatile LAS unsigned*)&xb_words);
    if (p.ph_lo > 1000) grid.sync();
    RUN_PHASE(0, phase_prologue(p, (float*)lds))
    RUN_PHASE(1, phase_prep(p, 0))
    RUN_PHASE(2, run_gemm1<0>(p, lds))
    RUN_PHASE(3, phase_mixers(p, 0, lds, 0))
    RUN_PHASE(4, phase_combine(p, 0); conv_win(p, 1, (float*)lds, blockIdx.x, gridDim.x))
    RUN_PHASE(5, run_gemm2<0>(p, lds))
    RUN_PHASE(6, phase_prep(p, 1))
    RUN_PHASE(7, run_gemm1<1>(p, lds))
    RUN_PHASE(8, phase_mixers(p, 1, lds, 1))
    RUN_PHASE(9, phase_combine(p, 1))
    RUN_PHASE(10, run_gemm2<1>(p, lds))
    RUN_PHASE(11, phase_final(p))
#ifdef PROBE_SYNC
    for (int i = 0; i < PROBE_SYNC; ++i) grid.sync();
#endif
}

extern "C" void kernel_launch(void* const* d_in, const int* in_sizes, int n_in, void* d_out, int out_size, void* d_ws, size_t ws_size, hipStream_t stream) {
    static int grid_blocks = 0;
    if (!grid_blocks) {
        int dev = 0, cus = 0, per_cu = 0;
        hipGetDevice(&dev);
        hipDeviceGetAttribute(&cus, hipDeviceAttributeMultiprocessorCount, dev);
        hipFuncSetAttribute((const void*)mega, hipFuncAttributeMaxDynamicSharedMemorySize, LDS_BYTES);
        hipOccupancyMaxActiveBlocksPerMultiprocessor(&per_cu, (const void*)mega, 512, LDS_BYTES);
        if (per_cu < 1) per_cu = 1;
        grid_blocks = cus * per_cu;
    }
    Params p{};
    const float** pin = (const float**)&p;
    for (int i = 0; i < 26; ++i) pin[i] = (const float*)d_in[i];
    p.out = (float*)d_out;
    unsigned char* ws = (unsigned char*)d_ws;
    size_t off = 0;
    auto take = [&](size_t bytes) { unsigned char* r = ws + off; off += (bytes + 255) & ~(size_t)255; return r; };
    p.bar = (unsigned*)take(XCD_BAR_WORDS * 4);
    p.ctr = (unsigned*)take(256);
    p.mod = (float*)take(2 * 5 * 6144 * 4);
    p.bscal = (float*)take((size_t)2 * NTOK * 12 * 4);
    p.rwT = (h16*)take((size_t)2 * 2 * 2 * 12 * 64 * 64 * 2);
    p.wT_in = (h16*)take((size_t)INWP * D * 2);
    p.wT_out = (h16*)take((size_t)2 * D * D * 2);
    p.hbuf = (h16*)take((size_t)NTOK * D * 2);
    p.z = (h16*)take((size_t)NTOK * INW * 2);
    p.gla_of = (h16*)take((size_t)NTOK * 768 * 2);
    p.gla_ob = (h16*)take((size_t)NTOK * 768 * 2);
    p.rw_yf = (h16*)take((size_t)NTOK * 768 * 2);
    p.rw_yb = (h16*)take((size_t)NTOK * 768 * 2);
    if (off > ws_size) { fprintf(stderr, "workspace too small: need %zu have %zu\n", off, ws_size); return; }
    hipMemsetAsync(p.bar, 0, ((XCD_BAR_WORDS * 4 + 255) & ~255) + 256, stream);
#if MULTI_LAUNCH
    for (int ph = 0; ph < NPHASE; ++ph) { p.ph_lo = ph; p.ph_hi = ph + 1;
        const int reps = ((PROBE_REP >> ph) & 1) ? 2 : 1;
        for (int r = 0; r < reps; ++r) { if (r) hipMemsetAsync(p.ctr, 0, 256, stream); p.sub = r ? PROBE_SUB : 31;
            hipLaunchKernelGGL(mega, dim3(grid_blocks), dim3(512), LDS_BYTES, stream, p); } }
#else
    p.ph_lo = 0; p.ph_hi = NPHASE; p.sub = 31;
    void* args[] = {&p};
    hipError_t e = hipLaunchCooperativeKernel((const void*)mega, dim3(grid_blocks), dim3(512), args, LDS_BYTES, stream);
    if (e != hipSuccess) fprintf(stderr, "cooperative launch failed: %s (grid %d)\n", hipGetErrorString(e), grid_blocks);
#endif
}
```

```cpp
#include <hip/hip_runtime.h>
#include <hip/hip_cooperative_groups.h>
#include <cstdio>
namespace cg = cooperative_groups;

#ifndef PROBE_REP
#define PROBE_REP 0
#endif
#ifndef PROBE_SUB
#define PROBE_SUB 31
#endif
#ifndef MULTI_LAUNCH
#define MULTI_LAUNCH 0
#endif

typedef _Float16 h16;
typedef _Float16 h16x8 __attribute__((ext_vector_type(8)));
typedef _Float16 h16x4 __attribute__((ext_vector_type(4)));
typedef _Float16 h16x2 __attribute__((ext_vector_type(2)));
typedef short s16x8 __attribute__((ext_vector_type(8)));
typedef float f32x4 __attribute__((ext_vector_type(4)));
typedef float f32x2 __attribute__((ext_vector_type(2)));
typedef unsigned u32x4 __attribute__((ext_vector_type(4)));
#define LAS __attribute__((address_space(3)))

constexpr int D = 2048, NTOK = 16384, NCTX = 8192, INW = 7056, INWP = 7168;
constexpr int LDS_BYTES = 147456;
constexpr int ZQ = 0, ZK = 384, ZV = 768, ZGG = 1536, ZLORA = 2304, ZCU = 2320, ZCV = 2832, ZCG = 3344,
              ZRR = 3856, ZRK = 4624, ZRV = 5392, ZRG = 6160, ZWL = 6928, ZAL = 6992;
constexpr size_t OUT_SG = (size_t)NTOK * D, OUT_SR = OUT_SG + 32ull * 2 * 2 * 6 * 64 * 128;

struct Params {
    const float *x_prompt, *x_sample, *state_gla, *state_rwkv, *c, *c_ctx, *w_mod, *b_mod, *norm_w, *w_in, *w_out,
        *gla_a2, *gla_a_bias, *gla_norm_w, *cm_norm_w, *cm_ws, *cm_bs, *rw_w0, *rw_w2, *rw_a0, *rw_a2, *rw_kk, *rw_ka, *rw_rk, *rw_gn_w, *final_norm_w;
    float* out;
    float* mod;
    unsigned* ctr;
    unsigned* bar;
    h16 *wT_in, *wT_out, *hbuf, *z, *gla_of, *gla_ob, *rw_yf, *rw_yb;
    float* bscal;
    h16* rwT;
    int ph_lo, ph_hi, sub, pad_;
};

__device__ __forceinline__ float silu_f(float x) { return x / (1.f + __expf(-x)); }
__device__ __forceinline__ float sigmoid_f(float x) { return 1.f / (1.f + __expf(-x)); }
template <int CTRL> __device__ __forceinline__ float dppf(float x) { return __int_as_float(__builtin_amdgcn_update_dpp(0, __float_as_int(x), CTRL, 0xF, 0xF, true)); }
__device__ __forceinline__ float red16(float x) { x += dppf<0xB1>(x); x += dppf<0x4E>(x); x += dppf<0x141>(x); x += dppf<0x140>(x); return x; }
__device__ __forceinline__ float red8(float x) { x += dppf<0xB1>(x); x += dppf<0x4E>(x); x += dppf<0x141>(x); return x; }
__device__ __forceinline__ float red64(float x) { x = red16(x); x += __shfl_xor(x, 16); x += __shfl_xor(x, 32); return x; }
__device__ __forceinline__ unsigned short f2bf(float f) { unsigned u = __float_as_uint(f); u += 0x7FFFu + ((u >> 16) & 1u); return (unsigned short)(u >> 16); }


#define XB_TMO      128
#define XB_XCNT(j)  (256  + 64 * (j))
#define XB_XSUB(j)  (1280 + 64 * (j))
#define XB_XGEN(j)  (2304 + 64 * (j))
#define XB_TOP      3328
#define XB_TOPGEN   3392
#define XCD_BAR_WORDS 3456
#define XB_SPIN_CAP (1u << 22)
__device__ __forceinline__ unsigned xb_ld(unsigned* p)              { return __hip_atomic_load(p, __ATOMIC_RELAXED, __HIP_MEMORY_SCOPE_AGENT); }
__device__ __forceinline__ unsigned xb_add(unsigned* p, unsigned v) { return __hip_atomic_fetch_add(p, v, __ATOMIC_RELAXED, __HIP_MEMORY_SCOPE_AGENT); }
__device__ __forceinline__ unsigned xb_xcc_id() { return (unsigned)__builtin_amdgcn_s_getreg((3 << 11) | 20) & 0xFu; }
#define XB_SPIN(cond, bar) do { unsigned _sp = 0; while (cond) { __builtin_amdgcn_s_sleep(1); \
    if ((++_sp & 255u) == 0u) { if (xb_ld(&(bar)[XB_TMO])) break; if (_sp > XB_SPIN_CAP) { atomicAdd(&(bar)[XB_TMO], 1u); break; } } } } while (0)
struct XcdBarrier { unsigned* bar; unsigned x; volatile LAS unsigned* st; };
__device__ __forceinline__ XcdBarrier xcd_barrier_post(unsigned* bar, volatile LAS unsigned* st) {
    XcdBarrier b; b.bar = bar; b.x = xb_xcc_id(); b.st = st;
    if (threadIdx.x == 0) (void)xb_add(&bar[XB_XCNT(b.x)], 1u);
    return b;
}
__device__ __forceinline__ void xcd_barrier_complete(unsigned* bar, unsigned x, unsigned& nloc, unsigned& nx) {
    const unsigned G = gridDim.x * gridDim.y * gridDim.z;
    unsigned sum, cnt, mine, sp = 0u;
    for (;;) {
        sum = 0u; cnt = 0u; mine = 0u;
#pragma unroll
        for (unsigned j = 0; j < 16; ++j) { const unsigned c = xb_ld(&bar[XB_XCNT(j)]); sum += c; cnt += (c > 0u) ? 1u : 0u; mine = (j == x) ? c : mine; }
        if (sum == G) break;
        __builtin_amdgcn_s_sleep(1);
        if ((++sp & 255u) == 0u) { if (xb_ld(&bar[XB_TMO])) break; if (sp > XB_SPIN_CAP) { atomicAdd(&bar[XB_TMO], 1u); break; } }
    }
    nloc = mine > 0u ? mine : 1u; nx = cnt > 0u ? cnt : 1u;
}
__device__ __forceinline__ void xcd_barrier(const XcdBarrier& b) {
    asm volatile("s_waitcnt vmcnt(0)" ::: "memory");
    __syncthreads();
    if (threadIdx.x == 0) {
        unsigned* bar = b.bar;
        __builtin_amdgcn_s_waitcnt(0);
        unsigned nloc = b.st[0], nx = b.st[1];
        if (nloc == 0u) { xcd_barrier_complete(bar, b.x, nloc, nx); b.st[0] = nloc; b.st[1] = nx; }
        const unsigned old = xb_add(&bar[XB_XSUB(b.x)], 1u);
        const unsigned gen = old / nloc;
        if (old + 1u == (gen + 1u) * nloc) {
            __builtin_amdgcn_fence(__ATOMIC_RELEASE, "agent");
            asm volatile("s_waitcnt vmcnt(0)" ::: "memory");
            const unsigned og = xb_add(&bar[XB_TOP], 1u);
            const unsigned tg = og / nx;
            if (og + 1u == (tg + 1u) * nx) xb_add(&bar[XB_TOPGEN], 1u);
            else XB_SPIN(xb_ld(&bar[XB_TOPGEN]) == tg, bar);
            __builtin_amdgcn_fence(__ATOMIC_ACQUIRE, "agent");
            xb_add(&bar[XB_XGEN(b.x)], 1u);
            asm volatile("s_waitcnt vmcnt(0)" ::: "memory");
        } else {
            XB_SPIN(xb_ld(&bar[XB_XGEN(b.x)]) == gen, bar);
            __builtin_amdgcn_fence(__ATOMIC_ACQUIRE, "agent");
            asm volatile("s_waitcnt vmcnt(0)" ::: "memory");
        }
    }
    __syncthreads();
}

namespace pg8 {
constexpr int BM = 256, BK = 64, HALF = 128, HTB = HALF * BK * 2, STAGE_BYTES = 8 * HTB, NXCD = 8, WGM = 4;
__host__ __device__ __forceinline__ int lds_byte(int r, int c) { const int st = (r >> 4) * 2 + (c >> 5), rr = r & 15, cc = c & 31, ob = rr * 64 + cc * 2; return st * 1024 + (ob ^ (((ob >> 9) & 1) << 5)); }
__host__ __device__ __forceinline__ void stage_rc(int b, int& R, int& C) { const int st = b / 1024, sb = b % 1024, swz = sb ^ (((sb >> 9) & 1) << 5); R = (st >> 1) * 16 + swz / 64; C = (st & 1) * 32 + (swz % 64) / 2; }
__host__ __device__ __forceinline__ int perm32(int rho) { const int n = rho >> 4, i = rho & 15; return 8 * (i >> 2) + 4 * n + (i & 3); }
struct Unit { int pm, pn; };
struct Gemm { const h16* A; const h16* Bt; int M, N, K; };
struct StaticOrder {
    int nM, nN, nwg, G, c;
    __host__ __device__ void init(int M, int N, int G_, int c_) { nM = M / BM; nN = N / BM; nwg = nM * nN; G = G_; c = c_; }
    __host__ __device__ bool next(int i, Unit& u) const {
        const long L = (long)i * G + c; if (L >= nwg) return false;
        int wgid = (int)L; { const int q = nwg / NXCD, r = nwg % NXCD, xcd = wgid % NXCD, off = wgid / NXCD; wgid = (xcd < r ? xcd * (q + 1) : r * (q + 1) + (xcd - r) * q) + off; }
        const int nig = WGM * nN, gid = wgid / nig, fm = gid * WGM, gsz = (nM - fm) < WGM ? (nM - fm) : WGM;
        u.pm = fm + ((wgid % nig) % gsz); u.pn = (wgid % nig) / gsz; return true;
    }
};

template <class Epi>
__device__ __forceinline__ void gemm_phase(LAS unsigned char* lds, const Gemm g, const StaticOrder& S, const Epi& E) {
    const int tid = threadIdx.x, wid = __builtin_amdgcn_readfirstlane(tid >> 6), lane = tid & 63, wr = wid >> 2, wc = wid & 3, fr = lane & 15, fq = lane >> 4;
    const int K = g.K, nt = K / BK;
    unsigned voffA[2], voffB[2];
#pragma unroll
    for (int i = 0; i < 2; ++i) { int R, C; stage_rc(tid * 16 + i * 8192, R, C); const int Rb = Epi::PERM ? ((R & ~31) + perm32(R & 31)) : R;
        voffA[i] = (unsigned)(R * K + C) * 2u; voffB[i] = (unsigned)(Rb * K + C) * 2u; }
    const size_t kstep = (size_t)(BK * 2);
    const size_t hstep = (size_t)HALF * K * 2;
    const size_t tstep = 2 * hstep;
    const unsigned ldsw = (unsigned)wid * 1024u;
    const int aoff = lds_byte(wr * 64 + fr, fq * 8), boff = lds_byte(wc * 32 + fr, fq * 8);
#define PG8_SA(b, h) (((b) * 2 + (h)) * HTB)
#define PG8_SB(b, h) ((4 + (b) * 2 + (h)) * HTB)
#define PG8_STAGE(bufoff, gbase, voff) do { _Pragma("unroll") for (int _i = 0; _i < 2; ++_i) \
        __builtin_amdgcn_global_load_lds((const unsigned*)((const char*)(gbase) + (voff)[_i]), (LAS unsigned*)(lds + (bufoff) + ldsw + _i * 8192), 16, 0, 0); } while (0)
#define PG8_LDA(dst, b, h) do { _Pragma("unroll") for (int m = 0; m < 4; ++m) _Pragma("unroll") for (int k = 0; k < 2; ++k) dst[m][k] = *(const LAS h16x8*)(lds + PG8_SA(b, h) + aoff + m * 2048 + k * 1024); } while (0)
#define PG8_LDB(dst, b, h) do { _Pragma("unroll") for (int n = 0; n < 2; ++n) _Pragma("unroll") for (int k = 0; k < 2; ++k) dst[n][k] = *(const LAS h16x8*)(lds + PG8_SB(b, h) + boff + n * 2048 + k * 1024); } while (0)
#define PG8_MMA(ai, bj, At, Bt) do { __builtin_amdgcn_s_setprio(1); _Pragma("unroll") for (int m = 0; m < 4; ++m) _Pragma("unroll") for (int n = 0; n < 2; ++n) _Pragma("unroll") for (int k = 0; k < 2; ++k) \
        acc[ai][bj][m][n] = __builtin_amdgcn_mfma_f32_16x16x32_f16(Bt[n][k], At[m][k], acc[ai][bj][m][n], 0, 0, 0); __builtin_amdgcn_s_setprio(0); } while (0)
#define PG8_WAIT_V(n) asm volatile("s_waitcnt vmcnt(" #n ")" ::: "memory")
#define PG8_WAIT_L(n) asm volatile("s_waitcnt lgkmcnt(" #n ")" ::: "memory")
#define PG8_BAR __builtin_amdgcn_s_barrier()
#define PG8_SCHED __builtin_amdgcn_sched_barrier(0)
    Unit cur, nxt; int ui = 0;
    if (!S.next(0, cur)) return;
    f32x4 acc[2][2][4][2];
#pragma unroll
    for (int a = 0; a < 2; ++a)
#pragma unroll
        for (int b = 0; b < 2; ++b)
#pragma unroll
            for (int m = 0; m < 4; ++m)
#pragma unroll
                for (int n = 0; n < 2; ++n) acc[a][b][m][n] = (f32x4){0.f, 0.f, 0.f, 0.f};
    h16x8 At[4][2], B0[2][2], B1[2][2];
    const char* cA = (const char*)g.A + (size_t)cur.pm * tstep; const char* cB = (const char*)g.Bt + (size_t)cur.pn * tstep;
    PG8_STAGE(PG8_SB(0, 0), cB, voffB); PG8_STAGE(PG8_SA(0, 0), cA, voffA); PG8_STAGE(PG8_SB(0, 1), cB + hstep, voffB); PG8_STAGE(PG8_SA(0, 1), cA + hstep, voffA);
    if (wr == 1) PG8_BAR;
    PG8_WAIT_V(4); PG8_BAR;
    PG8_STAGE(PG8_SB(1, 0), cB + kstep, voffB); PG8_STAGE(PG8_SA(1, 0), cA + kstep, voffA); PG8_STAGE(PG8_SB(1, 1), cB + hstep + kstep, voffB);
    PG8_WAIT_V(6); PG8_BAR;
    for (;;) {
        const bool has_next = S.next(ui + 1, nxt);
        const char* nA = has_next ? (const char*)g.A + (size_t)nxt.pm * tstep : cA; const char* nB = has_next ? (const char*)g.Bt + (size_t)nxt.pn * tstep : cB;
        for (int t = 0; t < nt; t += 2) {
            const bool last = (t == nt - 2);
            const char* a1 = cA + (size_t)(t + 1) * kstep;
            const char* a2 = last ? nA : cA + (size_t)(t + 2) * kstep; const char* b2 = last ? nB : cB + (size_t)(t + 2) * kstep;
            const char* a3 = a2 + kstep; const char* b3 = b2 + kstep;
            PG8_LDB(B0, 0, 0); PG8_SCHED; PG8_LDA(At, 0, 0); PG8_STAGE(PG8_SA(1, 1), a1 + hstep, voffA);
            PG8_WAIT_L(8); PG8_BAR; PG8_WAIT_L(0); PG8_MMA(0, 0, At, B0); PG8_BAR; PG8_SCHED;
            PG8_LDB(B1, 0, 1); PG8_STAGE(PG8_SB(0, 0), b2, voffB);
            PG8_BAR; PG8_WAIT_L(0); PG8_MMA(0, 1, At, B1); PG8_BAR;
            PG8_LDA(At, 0, 1); PG8_STAGE(PG8_SA(0, 0), a2, voffA);
            PG8_BAR; PG8_WAIT_L(0); PG8_MMA(1, 0, At, B0); PG8_BAR; PG8_SCHED;
            PG8_STAGE(PG8_SB(0, 1), b2 + hstep, voffB);
            PG8_WAIT_V(6); PG8_BAR; PG8_MMA(1, 1, At, B1); PG8_BAR;
            PG8_LDB(B0, 1, 0); PG8_SCHED; PG8_LDA(At, 1, 0); PG8_STAGE(PG8_SA(0, 1), a2 + hstep, voffA);
            PG8_WAIT_L(8); PG8_BAR; PG8_WAIT_L(0); PG8_MMA(0, 0, At, B0); PG8_BAR; PG8_SCHED;
            PG8_LDB(B1, 1, 1); PG8_STAGE(PG8_SB(1, 0), b3, voffB);
            PG8_BAR; PG8_WAIT_L(0); PG8_MMA(0, 1, At, B1); PG8_BAR;
            PG8_LDA(At, 1, 1); PG8_STAGE(PG8_SA(1, 0), a3, voffA);
            PG8_BAR; PG8_WAIT_L(0); PG8_MMA(1, 0, At, B0); PG8_BAR; PG8_SCHED;
            PG8_STAGE(PG8_SB(1, 1), b3 + hstep, voffB);
            PG8_WAIT_V(6); PG8_BAR; PG8_MMA(1, 1, At, B1); PG8_BAR;
        }
        E(acc, cur, wr, wc, fr, fq);
        if (!has_next) break;
#pragma unroll
        for (int a = 0; a < 2; ++a)
#pragma unroll
            for (int b = 0; b < 2; ++b)
#pragma unroll
                for (int m = 0; m < 4; ++m)
#pragma unroll
                    for (int n = 0; n < 2; ++n) acc[a][b][m][n] = (f32x4){0.f, 0.f, 0.f, 0.f};
        cur = nxt; cA = nA; cB = nB; ++ui;
    }
    PG8_WAIT_V(0);
    if (wr == 0) PG8_BAR;
    PG8_BAR;
#undef PG8_SA
#undef PG8_SB
#undef PG8_STAGE
#undef PG8_LDA
#undef PG8_LDB
#undef PG8_MMA
#undef PG8_WAIT_V
#undef PG8_WAIT_L
#undef PG8_BAR
#undef PG8_SCHED
}

struct EpiZ {
    static constexpr bool PERM = true;
    h16* Z;
    __device__ __forceinline__ void operator()(const f32x4 (&acc)[2][2][4][2], const Unit& u, int wr, int wc, int fr, int fq) const {
        const int row0 = u.pm * BM + wr * 64 + fr, col0 = u.pn * BM + wc * 32 + 8 * fq;
#pragma unroll
        for (int ai = 0; ai < 2; ++ai)
#pragma unroll
            for (int m = 0; m < 4; ++m) { h16* rowp = Z + (size_t)(row0 + ai * HALF + m * 16) * INW;
#pragma unroll
                for (int bj = 0; bj < 2; ++bj) { const int col = col0 + bj * HALF;
                    if (col < INW) { const f32x4 v0 = acc[ai][bj][m][0], v1 = acc[ai][bj][m][1];
                        h16x8 w; w[0] = (h16)v0[0]; w[1] = (h16)v0[1]; w[2] = (h16)v0[2]; w[3] = (h16)v0[3]; w[4] = (h16)v1[0]; w[5] = (h16)v1[1]; w[6] = (h16)v1[2]; w[7] = (h16)v1[3];
                        *(h16x8*)(rowp + col) = w; } } }
    }
};
struct EpiRes {
    static constexpr bool PERM = true;
    const h16* xin; h16* xout; const float* gate;
    __device__ __forceinline__ void operator()(const f32x4 (&acc)[2][2][4][2], const Unit& u, int wr, int wc, int fr, int fq) const {
        const int row0 = u.pm * BM + wr * 64 + fr, col0 = u.pn * BM + wc * 32 + 8 * fq;
        const int r00 = u.pm * BM, cond = r00 < NCTX ? 0 : 1 + ((r00 - NCTX) >> 11);
        const float* gr = gate + cond * 6144;
        f32x4 g0[2], g1[2];
#pragma unroll
        for (int bj = 0; bj < 2; ++bj) { g0[bj] = *(const f32x4*)(gr + col0 + bj * HALF); g1[bj] = *(const f32x4*)(gr + col0 + bj * HALF + 4); }
        h16x8 xv[2][4][2];
#pragma unroll
        for (int ai = 0; ai < 2; ++ai)
#pragma unroll
            for (int m = 0; m < 4; ++m)
#pragma unroll
                for (int bj = 0; bj < 2; ++bj) xv[ai][m][bj] = __builtin_nontemporal_load((const h16x8*)(xin + (size_t)(row0 + ai * HALF + m * 16) * D + col0 + bj * HALF));
#pragma unroll
        for (int ai = 0; ai < 2; ++ai)
#pragma unroll
            for (int m = 0; m < 4; ++m) { const int r = row0 + ai * HALF + m * 16;
#pragma unroll
                for (int bj = 0; bj < 2; ++bj) { const int c = col0 + bj * HALF;
                    const f32x4 v0 = acc[ai][bj][m][0], v1 = acc[ai][bj][m][1];
                    h16x8 w;
#pragma unroll
                    for (int e = 0; e < 4; ++e) { w[e] = (h16)((float)xv[ai][m][bj][e] + g0[bj][e] * v0[e]); w[4 + e] = (h16)((float)xv[ai][m][bj][4 + e] + g1[bj][e] * v1[e]); }
                    *(h16x8*)(xout + (size_t)r * D + c) = w; } }
    }
};
}

__device__ __forceinline__ void conv_tile(const float* src, int ld, int nvalid, h16* dst, int k0, int n0, float* tile  ) {
    const int tid = threadIdx.x;
    float v[16];
#pragma unroll
    for (int i = 0; i < 16; ++i) { const int e = tid + i * 512, kk = e >> 6, nn = e & 63;
        v[i] = (n0 + nn < nvalid) ? __builtin_nontemporal_load(src + (size_t)(k0 + kk) * ld + n0 + nn) : 0.f; }
#pragma unroll
    for (int i = 0; i < 16; ++i) { const int e = tid + i * 512, kk = e >> 6, nn = e & 63; tile[kk * 65 + nn] = v[i]; }
    __syncthreads();
    { const int nn = tid >> 3, ks = (tid & 7) * 16; h16x8 w0, w1;
#pragma unroll
        for (int j = 0; j < 8; ++j) { w0[j] = (h16)tile[(ks + j) * 65 + nn]; w1[j] = (h16)tile[(ks + 8 + j) * 65 + nn]; }
        *(h16x8*)(dst + (size_t)(n0 + nn) * 2048 + k0 + ks) = w0; *(h16x8*)(dst + (size_t)(n0 + nn) * 2048 + k0 + ks + 8) = w1; }
    __syncthreads();
}

__device__ void conv_win(const Params& p, int l, float* ldsf, int t0, int tstride) {
    for (int t = t0; t < 16 * 112; t += tstride) { const int kt = t & 15, ntile = t >> 4;
        conv_tile(p.w_in + (size_t)l * D * INW, INW, INW, p.wT_in, kt * 128, ntile * 64, ldsf); }
}

__device__ void phase_prologue(const Params& p, float* ldsf) {
    const int tid = threadIdx.x;
    for (int t = blockIdx.x; t < 192 + 1024 + 1792 + 96; t += gridDim.x) {
        if (t >= 192 + 1024 + 1792) {
            const int o8 = (t - (192 + 1024 + 1792)) * 512 + tid;
            const int j0 = (o8 & 7) * 8, c = (o8 >> 3) & 63, hh = (o8 >> 9) % 12, m = ((o8 >> 9) / 12) & 1, ld = (o8 >> 9) / 24;
            const float* src = (m ? p.rw_a2 : p.rw_w2) + (size_t)ld * 64 * 768 + hh * 64 + c;
            h16x8 w;
#pragma unroll
            for (int e = 0; e < 8; ++e) w[e] = (h16)src[(size_t)(j0 + e) * 768];
            *(h16x8*)(p.rwT + (size_t)o8 * 8) = w;
        } else if (t < 192) {
            const int l = t / 96, cc = (t % 96) * 64;
            float* sc = ldsf;
            float* red = ldsf + 5 * 2048;
            for (int i = tid; i < 5 * 2048; i += 512) { const int cnd = i >> 11, k = i & 2047; const float v = cnd == 0 ? p.c_ctx[k] : p.c[(cnd - 1) * 2048 + k]; sc[i] = silu_f(v); }
            __syncthreads();
            const int col = cc + (tid & 63), kg = tid >> 6;
            float a0 = 0, a1 = 0, a2 = 0, a3 = 0, a4 = 0;
            const float* wp = p.w_mod + (size_t)l * D * 6144 + col;
#pragma unroll 64
            for (int k = kg; k < 2048; k += 8) { const float w = __builtin_nontemporal_load(wp + (size_t)k * 6144);
                a0 += sc[k] * w; a1 += sc[2048 + k] * w; a2 += sc[4096 + k] * w; a3 += sc[6144 + k] * w; a4 += sc[8192 + k] * w; }
            red[(kg * 5 + 0) * 64 + (tid & 63)] = a0; red[(kg * 5 + 1) * 64 + (tid & 63)] = a1; red[(kg * 5 + 2) * 64 + (tid & 63)] = a2;
            red[(kg * 5 + 3) * 64 + (tid & 63)] = a3; red[(kg * 5 + 4) * 64 + (tid & 63)] = a4;
            __syncthreads();
            if (tid < 320) { const int cnd = tid >> 6, cl = tid & 63; float s = p.b_mod[l * 6144 + cc + cl];
#pragma unroll
                for (int g = 0; g < 8; ++g) s += red[(g * 5 + cnd) * 64 + cl];
                p.mod[(size_t)(l * 5 + cnd) * 6144 + cc + cl] = s; }
            __syncthreads();
        } else if (t < 192 + 1024) {
            const int u = t - 192, l = u >> 9, kt = u & 15, ntile = (u >> 4) & 31;
            conv_tile(p.w_out + (size_t)l * D * D, D, D, p.wT_out + (size_t)l * D * D, kt * 128, ntile * 64, ldsf);
        } else {
            const int u = t - 192 - 1024, kt = u & 15, ntile = u >> 4;
            conv_tile(p.w_in, INW, INW, p.wT_in, kt * 128, ntile * 64, ldsf);
        }
    }
}

__device__ __forceinline__ void load_row_f32(const float* xr, int lane, f32x4 (&xv)[8]) {
#pragma unroll
    for (int j = 0; j < 8; ++j) xv[j] = __builtin_nontemporal_load((const f32x4*)(xr + (j * 64 + lane) * 4));
}
__device__ __forceinline__ void load_row_h16_nt(const h16* xr, int lane, f32x4 (&xv)[8]) {
#pragma unroll
    for (int j = 0; j < 8; ++j) { const h16x4 t = __builtin_nontemporal_load((const h16x4*)(xr + (j * 64 + lane) * 4)); xv[j] = (f32x4){(float)t[0], (float)t[1], (float)t[2], (float)t[3]}; }
}
__device__ __forceinline__ void load_row_h16(const h16* xr, int lane, f32x4 (&xv)[8]) {
#pragma unroll
    for (int j = 0; j < 8; ++j) { const h16x4 t = *(const h16x4*)(xr + (j * 64 + lane) * 4); xv[j] = (f32x4){(float)t[0], (float)t[1], (float)t[2], (float)t[3]}; }
}
__device__ void phase_prep(const Params& p, int l) {
    const int lane = threadIdx.x & 63, wid = threadIdx.x >> 6;
    const float* nw = p.norm_w + l * D;
    h16* x0h = (h16*)p.out;
    const h16* x1h = (const h16*)p.out + (size_t)NTOK * D;
    const int stride = gridDim.x * 8;
    int r = blockIdx.x * 8 + wid;
    f32x4 xv[8], xn[8];
    auto load = [&](int rr, f32x4 (&dst)[8]) {
        if (l == 0) load_row_f32(rr < NCTX ? p.x_prompt + (size_t)rr * D : p.x_sample + (size_t)(rr - NCTX) * D, lane, dst);
        else load_row_h16_nt(x1h + (size_t)rr * D, lane, dst);
    };
    if (r < NTOK) load(r, xv);
    while (r < NTOK) {
        const int rn = r + stride;
        if (rn < NTOK) load(rn, xn);
        const int cond = r < NCTX ? 0 : 1 + ((r - NCTX) >> 11);
        const float* mb = p.mod + (size_t)(l * 5 + cond) * 6144;
        float ss = 0.f;
        if (l == 0) {
#pragma unroll
            for (int j = 0; j < 8; ++j) { h16x4 o; o[0] = (h16)xv[j][0]; o[1] = (h16)xv[j][1]; o[2] = (h16)xv[j][2]; o[3] = (h16)xv[j][3]; *(h16x4*)(x0h + (size_t)r * D + (j * 64 + lane) * 4) = o; } }
#pragma unroll
        for (int j = 0; j < 8; ++j) ss += xv[j][0] * xv[j][0] + xv[j][1] * xv[j][1] + xv[j][2] * xv[j][2] + xv[j][3] * xv[j][3];
        ss = red64(ss);
        const float rs = rsqrtf(ss * (1.f / 2048.f) + 1e-6f);
#pragma unroll
        for (int j = 0; j < 8; ++j) { const int k = (j * 64 + lane) * 4;
            const f32x4 w = *(const f32x4*)(nw + k), sh = *(const f32x4*)(mb + k), scl = *(const f32x4*)(mb + 2048 + k);
            h16x4 o;
#pragma unroll
            for (int e = 0; e < 4; ++e) o[e] = (h16)(xv[j][e] * rs * w[e] * (1.f + scl[e]) + sh[e]);
            *(h16x4*)(p.hbuf + (size_t)r * D + k) = o; }
#pragma unroll
        for (int j = 0; j < 8; ++j) xv[j] = xn[j];
        r = rn;
    }
}

__device__ void phase_final(const Params& p) {
    const int lane = threadIdx.x & 63, wid = threadIdx.x >> 6;
    const h16* x2h = p.gla_of;
    const int stride = gridDim.x * 8;
    int r = blockIdx.x * 8 + wid;
    f32x4 xv[8], xn[8];
    if (r < NTOK) load_row_h16_nt(x2h + (size_t)r * D, lane, xv);
    while (r < NTOK) {
        const int rn = r + stride;
        if (rn < NTOK) load_row_h16_nt(x2h + (size_t)rn * D, lane, xn);
        float* yr = p.out + (size_t)r * D;
        float ss = 0.f;
#pragma unroll
        for (int j = 0; j < 8; ++j) ss += xv[j][0] * xv[j][0] + xv[j][1] * xv[j][1] + xv[j][2] * xv[j][2] + xv[j][3] * xv[j][3];
        ss = red64(ss);
        const float rs = rsqrtf(ss * (1.f / 2048.f) + 1e-6f);
#pragma unroll
        for (int j = 0; j < 8; ++j) { const int k = (j * 64 + lane) * 4; const f32x4 w = *(const f32x4*)(p.final_norm_w + k);
            __builtin_nontemporal_store(xv[j] * rs * w, (f32x4*)(yr + k)); }
#pragma unroll
        for (int j = 0; j < 8; ++j) xv[j] = xn[j];
        r = rn;
    }
}

__device__ __forceinline__ float silu_fast(float x) { return x * __builtin_amdgcn_rcpf(1.f + __expf(-x)); }
__device__ void phase_combine(const Params& p, int l) {
    const int lane = threadIdx.x & 63, wid = threadIdx.x >> 6;
    const bool lo = lane < 32;
    int cg[2], cr[2], hd[2];
    cg[0] = (lane >> 4) * 128 + (lane & 15) * 8; cg[1] = lo ? (4 + (lane >> 4)) * 128 + (lane & 15) * 8 : 0;
    hd[0] = lane >> 3; hd[1] = lo ? 8 + (lane >> 3) : 0;
    cr[0] = hd[0] * 64 + (lane & 7) * 8; cr[1] = hd[1] * 64 + (lane & 7) * 8;
    f32x4 wg[2][2], wr[2][2];
#pragma unroll
    for (int ps = 0; ps < 2; ++ps) { wg[ps][0] = *(const f32x4*)(p.gla_norm_w + l * 768 + cg[ps]); wg[ps][1] = *(const f32x4*)(p.gla_norm_w + l * 768 + cg[ps] + 4);
        wr[ps][0] = *(const f32x4*)(p.rw_gn_w + l * 768 + cr[ps]); wr[ps][1] = *(const f32x4*)(p.rw_gn_w + l * 768 + cr[ps] + 4); }
    for (int r = blockIdx.x * 8 + wid; r < NTOK; r += gridDim.x * 8) {
        const h16* zr = p.z + (size_t)r * INW; h16* orow = p.hbuf + (size_t)r * D;
        h16x8 ga[2], gb[2], gg[2], ra[2], rb[2], rv[2], rg[2]; float bs[2];
        const h16x8 zero8 = {0, 0, 0, 0, 0, 0, 0, 0};
#pragma unroll
        for (int ps = 0; ps < 2; ++ps) {
            if (ps == 0 || lo) {
                ga[ps] = __builtin_nontemporal_load((const h16x8*)(p.gla_of + (size_t)r * 768 + cg[ps])); gb[ps] = __builtin_nontemporal_load((const h16x8*)(p.gla_ob + (size_t)r * 768 + cg[ps])); gg[ps] = __builtin_nontemporal_load((const h16x8*)(zr + ZGG + cg[ps]));
                ra[ps] = __builtin_nontemporal_load((const h16x8*)(p.rw_yf + (size_t)r * 768 + cr[ps])); rb[ps] = __builtin_nontemporal_load((const h16x8*)(p.rw_yb + (size_t)r * 768 + cr[ps]));
                rv[ps] = __builtin_nontemporal_load((const h16x8*)(zr + ZRV + cr[ps])); rg[ps] = __builtin_nontemporal_load((const h16x8*)(zr + ZRG + cr[ps]));
                bs[ps] = p.bscal[(size_t)r * 12 + hd[ps]] + p.bscal[(size_t)(NTOK + r) * 12 + hd[ps]];
            } else { ga[ps] = zero8; gb[ps] = zero8; gg[ps] = zero8; ra[ps] = zero8; rb[ps] = zero8; rv[ps] = zero8; rg[ps] = zero8; bs[ps] = 0.f; }
        }
#pragma unroll
        for (int ps = 0; ps < 2; ++ps) {
            float o[8]; float ss = 0.f;
#pragma unroll
            for (int e = 0; e < 8; ++e) { o[e] = (float)ga[ps][e] + (float)gb[ps][e]; ss += o[e] * o[e]; }
            ss = red16(ss);
            const float rs = rsqrtf(ss * (1.f / 128.f) + 1e-6f);
            h16x8 ov;
#pragma unroll
            for (int e = 0; e < 8; ++e) ov[e] = (h16)(o[e] * rs * (e < 4 ? wg[ps][0][e & 3] : wg[ps][1][e & 3]) * silu_fast((float)gg[ps][e]));
            if (ps == 0 || lo) *(h16x8*)(orow + cg[ps]) = ov;
        }
#pragma unroll
        for (int ps = 0; ps < 2; ++ps) {
            float y[8]; float sm = 0.f;
#pragma unroll
            for (int e = 0; e < 8; ++e) { y[e] = (float)ra[ps][e] + (float)rb[ps][e]; sm += y[e]; }
            const float mu = red8(sm) * (1.f / 64.f);
            float vs = 0.f;
#pragma unroll
            for (int e = 0; e < 8; ++e) { y[e] -= mu; vs += y[e] * y[e]; }
            const float rs = rsqrtf(red8(vs) * (1.f / 64.f) + 64e-5f);
            h16x8 ov;
#pragma unroll
            for (int e = 0; e < 8; ++e) ov[e] = (h16)((y[e] * rs * (e < 4 ? wr[ps][0][e & 3] : wr[ps][1][e & 3]) + bs[ps] * (float)rv[ps][e]) * silu_fast((float)rg[ps][e]));
            if (ps == 0 || lo) *(h16x8*)(orow + 1280 + cr[ps]) = ov;
        }
    }
}

__device__ __forceinline__ f32x4 mfma16(const h16x8 a, const h16x8 b, const f32x4 c) { return __builtin_amdgcn_mfma_f32_16x16x32_f16(a, b, c, 0, 0, 0); }
__device__ __forceinline__ f32x4 mfma16b(const s16x8 a, const s16x8 b, const f32x4 c) { return __builtin_amdgcn_mfma_f32_16x16x32_bf16(a, b, c, 0, 0, 0); }

__device__ void cm_unit(const Params& p, int l, int r0, int g, unsigned char* lds) {
    int tid_ = threadIdx.x; asm volatile("" : "+v"(tid_));
    const int tid = tid_, lane = tid & 63, wid = tid >> 6, fr = lane & 15, fq = lane >> 4;
    h16* Ws = (h16*)lds;
    h16* VnT = (h16*)(lds + 128 * 136 * 2);
    const float* ws = p.cm_ws + (size_t)(l * 4 + g) * 128 * 128;
    for (int e = tid; e < 128 * 32; e += 512) { const int i = e >> 5, j4 = (e & 31) * 4; const f32x4 v = *(const f32x4*)(ws + i * 128 + j4);
        h16x4 o; o[0] = (h16)v[0]; o[1] = (h16)v[1]; o[2] = (h16)v[2]; o[3] = (h16)v[3]; *(h16x4*)(Ws + i * 136 + j4) = o; }
    for (int j = wid; j < 128; j += 8) {
        const h16x2 v = *(const h16x2*)(p.z + (size_t)(r0 + j) * INW + ZCV + g * 128 + 2 * lane);
        const float v0 = (float)v[0], v1 = (float)v[1];
        const float rs = rsqrtf(red64(v0 * v0 + v1 * v1) * (1.f / 128.f) + 1e-6f);
        const f32x2 w = *(const f32x2*)(p.cm_norm_w + l * 512 + g * 128 + 2 * lane);
        VnT[(2 * lane) * 136 + j] = (h16)(v0 * rs * w[0]); VnT[(2 * lane + 1) * 136 + j] = (h16)(v1 * rs * w[1]);
    }
    __syncthreads();
    f32x4 acc[8];
#pragma unroll
    for (int ct = 0; ct < 8; ++ct) acc[ct] = (f32x4){0.f, 0.f, 0.f, 0.f};
#pragma unroll
    for (int ks = 0; ks < 4; ++ks) {
        const h16x8 a = *(const h16x8*)(Ws + (16 * wid + fr) * 136 + ks * 32 + fq * 8);
#pragma unroll
        for (int ct = 0; ct < 8; ++ct) { const h16x8 b = *(const h16x8*)(VnT + (ct * 16 + fr) * 136 + ks * 32 + fq * 8); acc[ct] = mfma16(b, a, acc[ct]); }
    }
    const int i = 16 * wid + fr; const float bias = p.cm_bs[(l * 4 + g) * 128 + i];
    const h16* zr = p.z + (size_t)(r0 + i) * INW; h16* orow = p.hbuf + (size_t)(r0 + i) * D + 768 + g * 128;
#pragma unroll
    for (int ct = 0; ct < 8; ++ct) { const int c = ct * 16 + fq * 4;
        const h16x4 u = *(const h16x4*)(zr + ZCU + g * 128 + c), gt = *(const h16x4*)(zr + ZCG + g * 128 + c);
        h16x4 o;
#pragma unroll
        for (int jj = 0; jj < 4; ++jj) o[jj] = (h16)((float)u[jj] * (acc[ct][jj] + bias) * silu_fast((float)gt[jj]));
        *(h16x4*)(orow + c) = o; }
    __syncthreads();
}

__device__ void gla_unit(const Params& p, int l, bool lat, int b, int h, int d, unsigned char* lds) {
    int tid_ = threadIdx.x; asm volatile("" : "+v"(tid_));
    const int tid = tid_, lane = tid & 63, wid = tid >> 6, fr = lane & 15, fq = lane >> 4;
    const int L = lat ? 2048 : 256, nch = L / 64;
    const int rbase = lat ? NCTX + b * 2048 : b * 256;
    h16* Qraw = (h16*)(lds);
    h16* Att = Qraw;
    h16* Kraw = (h16*)(lds + 9216);
    unsigned short* Qb = (unsigned short*)(lds + 2 * 9216);
    unsigned short* Kb = (unsigned short*)(lds + 3 * 9216);
    h16* Qh = (h16*)(lds + 4 * 9216);
    h16* KeT = (h16*)(lds + 5 * 9216);
    h16* Vt = (h16*)(lds + 6 * 9216);
    h16* St = (h16*)(lds + 6 * 9216 + 18432);
    float* Bc = (float*)(lds + 6 * 9216 + 2 * 18432);
    h16* A2T = (h16*)(Bc + 4096);
    h16* Lor = A2T + 64 * 24;
    h16* laT = Lor + 64 * 24;
    float* Abias = (float*)(laT + 64 * 72);
    float* Ebl = Abias + 64;
    float* Rc = Ebl + 64;
    float* Rs = Rc + 1024;
    for (int e = tid; e < 1024; e += 512) { const int r = e >> 6, kk = e & 63; A2T[kk * 24 + r] = (h16)p.gla_a2[((size_t)(l * 2 + d) * 16 + r) * 384 + h * 64 + kk]; }
    if (tid < 64) Abias[tid] = p.gla_a_bias[(l * 2 + d) * 384 + h * 64 + tid];
    if (lat) for (int e = tid; e < 1024; e += 512) { const int pos = e >> 4, c = e & 15; const float inv = __expf(-(float)c * (9.210340371976184f / 16.f)); float s, co; __sincosf((float)pos * inv, &s, &co); Rc[e] = co; Rs[e] = s; }
    f32x4 S[4];
    const float* s0 = lat ? p.state_gla + ((((size_t)b * 2 + l) * 2 + d) * 6 + h) * 64 * 128 : nullptr;
#pragma unroll
    for (int kt = 0; kt < 4; ++kt)
#pragma unroll
        for (int jj = 0; jj < 4; ++jj) S[kt][jj] = lat ? s0[(kt * 16 + fq * 4 + jj) * 128 + 16 * wid + fr] : 0.f;
    h16* obuf = d == 0 ? p.gla_of : p.gla_ob;
    const int prow = tid >> 3, pseg = tid & 7;
    h16x8 pq, pk, pv0, pv1, plo;
    auto tokof = [&](int n, int i) -> int { return d == 0 ? n * 64 + i : L - 64 * (n + 1) + 63 - i; };
    auto prefetch = [&](int n) {
        const h16* zr = p.z + (size_t)(rbase + tokof(n, prow)) * INW;
        pq = *(const h16x8*)(zr + ZQ + h * 64 + pseg * 8); pk = *(const h16x8*)(zr + ZK + h * 64 + pseg * 8);
        pv0 = *(const h16x8*)(zr + ZV + h * 128 + pseg * 16); pv1 = *(const h16x8*)(zr + ZV + h * 128 + pseg * 16 + 8);
        if (fq < 2) plo = *(const h16x8*)(p.z + (size_t)(rbase + tokof(n, (wid >> 1) * 16 + fr)) * INW + ZLORA + fq * 8);
    };
    prefetch(0);
    for (int n = 0; n < nch; ++n) {
        __syncthreads();
        *(h16x8*)(Qraw + prow * 72 + pseg * 8) = pq; *(h16x8*)(Kraw + prow * 72 + pseg * 8) = pk;
#pragma unroll
        for (int j = 0; j < 8; ++j) { Vt[(pseg * 16 + j) * 72 + prow] = pv0[j]; Vt[(pseg * 16 + 8 + j) * 72 + prow] = pv1[j]; }
#pragma unroll
        for (int kt = 0; kt < 4; ++kt) { h16x4 sv; sv[0] = (h16)S[kt][0]; sv[1] = (h16)S[kt][1]; sv[2] = (h16)S[kt][2]; sv[3] = (h16)S[kt][3];
            *(h16x4*)(St + (16 * wid + fr) * 72 + kt * 16 + fq * 4) = sv; }
        { const int it = wid >> 1; const h16x8 zero8 = {0, 0, 0, 0, 0, 0, 0, 0};
            const h16x8 lf = (fq < 2) ? plo : zero8;
#pragma unroll
            for (int t2 = 0; t2 < 2; ++t2) { const int kt = (wid & 1) * 2 + t2;
                const h16x8 af = (fq < 2) ? *(const h16x8*)(A2T + (kt * 16 + fr) * 24 + fq * 8) : zero8;
                const f32x4 zz = mfma16(af, lf, (f32x4){0.f, 0.f, 0.f, 0.f});
                const f32x4 bi = *(const f32x4*)(Abias + kt * 16 + fq * 4);
#pragma unroll
                for (int jj = 0; jj < 4; ++jj) { const float z1 = zz[jj] + bi[jj];
                    const float ls = fminf(z1, 0.f) - __logf(1.f + __expf(-fabsf(z1)));
                    laT[(kt * 16 + fq * 4 + jj) * 72 + it * 16 + fr] = (h16)fmaxf(ls * (1.f / 16.f), -1.f); } } }
        __syncthreads();
        if (n + 1 < nch) prefetch(n + 1);
        { const int it = wid >> 1; h16x8 lt[2];
#pragma unroll
            for (int kb = 0; kb < 2; ++kb)
#pragma unroll
                for (int e = 0; e < 8; ++e) lt[kb][e] = (kb * 32 + fq * 8 + e <= it * 16 + fr) ? (h16)1.f : (h16)0.f;
#pragma unroll
            for (int t2 = 0; t2 < 2; ++t2) { const int kt = (wid & 1) * 2 + t2; f32x4 bacc = (f32x4){0.f, 0.f, 0.f, 0.f};
#pragma unroll
                for (int kb = 0; kb < 2; ++kb) { const h16x8 lf = *(const h16x8*)(laT + (kt * 16 + fr) * 72 + kb * 32 + fq * 8); bacc = mfma16(lf, lt[kb], bacc); }
                *(f32x4*)(Bc + (it * 16 + fr) * 64 + kt * 16 + fq * 4) = bacc;
                if (it == 3 && fr == 15) { f32x4 eb; eb[0] = __expf(bacc[0]); eb[1] = __expf(bacc[1]); eb[2] = __expf(bacc[2]); eb[3] = __expf(bacc[3]); *(f32x4*)(Ebl + kt * 16 + fq * 4) = eb; } } }
        __syncthreads();
        { const int i = prow, a = pseg, k0 = a * 8;
            const h16x8 qo = *(const h16x8*)(Qraw + i * 72 + k0), ko = *(const h16x8*)(Kraw + i * 72 + k0);
            float qv[8], kv[8];
#pragma unroll
            for (int j = 0; j < 8; ++j) { qv[j] = (float)qo[j] * 0.125f; kv[j] = (float)ko[j]; }
            if (lat) {
                const h16x8 qp = *(const h16x8*)(Qraw + i * 72 + (k0 ^ 16)), kp = *(const h16x8*)(Kraw + i * 72 + (k0 ^ 16));
                const int tok = tokof(n, i); const int pos = (a < 4) ? (tok >> 6) : (tok & 63); const bool first = (a & 2) == 0; const int cb = (a & 1) * 8;
#pragma unroll
                for (int j = 0; j < 8; ++j) { const float co = Rc[pos * 16 + cb + j], si = Rs[pos * 16 + cb + j]; const float qpp = (float)qp[j] * 0.125f, kpp = (float)kp[j];
                    qv[j] = first ? (qv[j] * co - qpp * si) : (qpp * si + qv[j] * co);
                    kv[j] = first ? (kv[j] * co - kpp * si) : (kpp * si + kv[j] * co); }
            }
            s16x8 qb, kb; h16x8 qh;
#pragma unroll
            for (int j = 0; j < 8; ++j) { const float ee = __expf(Bc[i * 64 + k0 + j]);
                const float qt = qv[j] * ee, kt = kv[j] * __builtin_amdgcn_rcpf(ee), ke = kt * Ebl[k0 + j];
                qb[j] = (short)f2bf(qt); kb[j] = (short)f2bf(kt); qh[j] = (h16)qt; KeT[(k0 + j) * 72 + i] = (h16)ke; }
            *(s16x8*)(Qb + i * 72 + k0) = qb; *(s16x8*)(Kb + i * 72 + k0) = kb; *(h16x8*)(Qh + i * 72 + k0) = qh;
        }
        __syncthreads();
        f32x4 O[4];
#pragma unroll
        for (int it = 0; it < 4; ++it) O[it] = (f32x4){0.f, 0.f, 0.f, 0.f};
#pragma unroll
        for (int ks = 0; ks < 2; ++ks) { const h16x8 sb = *(const h16x8*)(St + (16 * wid + fr) * 72 + ks * 32 + fq * 8);
#pragma unroll
            for (int it = 0; it < 4; ++it) { const h16x8 qa = *(const h16x8*)(Qh + (it * 16 + fr) * 72 + ks * 32 + fq * 8); O[it] = mfma16(sb, qa, O[it]); } }
        { const int it = wid >> 1;
#pragma unroll
            for (int t2 = 0; t2 < 2; ++t2) { const int jt = (wid & 1) * 2 + t2; f32x4 at = (f32x4){0.f, 0.f, 0.f, 0.f};
                if (jt <= it) {
#pragma unroll
                    for (int ks = 0; ks < 2; ++ks) { const s16x8 qa = *(const s16x8*)(Qb + (it * 16 + fr) * 72 + ks * 32 + fq * 8), kb = *(const s16x8*)(Kb + (jt * 16 + fr) * 72 + ks * 32 + fq * 8);
                        at = mfma16b(kb, qa, at); } }
                h16x4 av;
#pragma unroll
                for (int jj = 0; jj < 4; ++jj) { const int i = it * 16 + fr, j = jt * 16 + fq * 4 + jj; av[jj] = (h16)((j <= i) ? at[jj] : 0.f); }
                *(h16x4*)(Att + (it * 16 + fr) * 72 + jt * 16 + fq * 4) = av; } }
        __syncthreads();
        { h16x8 vb[2];
#pragma unroll
            for (int ks = 0; ks < 2; ++ks) vb[ks] = *(const h16x8*)(Vt + (16 * wid + fr) * 72 + ks * 32 + fq * 8);
#pragma unroll
            for (int it = 0; it < 4; ++it)
#pragma unroll
                for (int ks = 0; ks < 2; ++ks) { const h16x8 aa = *(const h16x8*)(Att + (it * 16 + fr) * 72 + ks * 32 + fq * 8); O[it] = mfma16(vb[ks], aa, O[it]); }
#pragma unroll
            for (int kt = 0; kt < 4; ++kt) { const f32x4 bl = *(const f32x4*)(Ebl + kt * 16 + fq * 4);
                S[kt] = S[kt] * bl;
#pragma unroll
                for (int ks = 0; ks < 2; ++ks) { const h16x8 ka = *(const h16x8*)(KeT + (kt * 16 + fr) * 72 + ks * 32 + fq * 8); S[kt] = mfma16(ka, vb[ks], S[kt]); } }
        }
#pragma unroll
        for (int it = 0; it < 4; ++it) { const int tok = tokof(n, it * 16 + fr); h16x4 ov; ov[0] = (h16)O[it][0]; ov[1] = (h16)O[it][1]; ov[2] = (h16)O[it][2]; ov[3] = (h16)O[it][3];
            *(h16x4*)(obuf + (size_t)(rbase + tok) * 768 + h * 128 + 16 * wid + fq * 4) = ov; }
    }
    if (!lat) { float* so = p.out + OUT_SG + ((((size_t)b * 2 + l) * 2 + d) * 6 + h) * 64 * 128;
#pragma unroll
        for (int kt = 0; kt < 4; ++kt)
#pragma unroll
            for (int jj = 0; jj < 4; ++jj) __builtin_nontemporal_store(S[kt][jj], so + (kt * 16 + fq * 4 + jj) * 128 + 16 * wid + fr); }
    __syncthreads();
}

__device__ __forceinline__ h16x4 cvt4(const f32x4 a) { h16x4 r; r[0] = (h16)a[0]; r[1] = (h16)a[1]; r[2] = (h16)a[2]; r[3] = (h16)a[3]; return r; }
__device__ __forceinline__ f32x4 mm16(const h16x4 second, const h16x4 first, const f32x4 acc) {
    h16x8 f8, s8;
#pragma unroll
    for (int e = 0; e < 4; ++e) { f8[e] = first[e]; s8[e] = second[e]; f8[4 + e] = (h16)0.f; s8[4 + e] = (h16)0.f; }
    return __builtin_amdgcn_mfma_f32_16x16x32_f16(f8, s8, acc, 0, 0, 0); }
__device__ __forceinline__ f32x4 mm32(const h16x8 second, const h16x8 first, const f32x4 acc) { return __builtin_amdgcn_mfma_f32_16x16x32_f16(first, second, acc, 0, 0, 0); }
__device__ void rwkv_unit(const Params& p, int l, bool lat, int b, int h, int d, unsigned char* lds) {
    constexpr int T = 32;
    int tid_ = threadIdx.x; asm volatile("" : "+v"(tid_));
    const int tid = tid_, lane = tid & 63, wid = __builtin_amdgcn_readfirstlane(tid >> 6);
    const int L = lat ? 2048 : 256, nblk = L / T;
    const int rbase = lat ? NCTX + b * 2048 : b * 256;
    float* Wb = (float*)lds;
    h16* Hb = (h16*)(lds + 16384);
    h16* FR = (h16*)(lds + 57344);
    h16* OPa = (h16*)(lds + 75776);
    h16* OPt = (h16*)(lds + 75776 + 6 * T * 72 * 2);
    float* Gf = (float*)(lds + 75776 + 6 * T * 72 * 2 + 3 * 2 * 64 * 20 * 2);
    h16* ybuf = d == 0 ? p.rw_yf : p.rw_yb;
    float* bsc = p.bscal + (size_t)d * NTOK * 12;
    auto tokof = [&](int s) -> int { return d == 0 ? s : L - 1 - s; };
    const bool chain = wid < 4;
    const int fr = lane & 15, fq = lane >> 4;
    const int v0 = 16 * (wid & 3);
    f32x4 S[4];
    const int pw = wid & 3, ts = fr & 7, chalf = fr >> 3;
    if (chain) {
        if (lat) { const float* s0 = p.state_rwkv + ((((size_t)b * 2 + l) * 2 + d) * 12 + h) * 4096;
#pragma unroll
            for (int kt = 0; kt < 4; ++kt) S[kt] = *(const f32x4*)(s0 + (v0 + fr) * 64 + kt * 16 + fq * 4);
        } else {
#pragma unroll
            for (int kt = 0; kt < 4; ++kt) S[kt] = (f32x4){0.f, 0.f, 0.f, 0.f}; }
    } else {
    }
    h16x8 pwl[2], pal[2]; h16x4 prv[2], pkv[2], pvv[2];
    auto pf_load = [&](int nb) {
        const h16* zr = p.z + (size_t)(rbase + tokof(nb * T + pw * 8 + ts)) * INW;
#pragma unroll
        for (int kb = 0; kb < 2; ++kb) { pwl[kb] = *(const h16x8*)(zr + ZWL + kb * 32 + fq * 8); pal[kb] = *(const h16x8*)(zr + ZAL + kb * 32 + fq * 8); }
#pragma unroll
        for (int u = 0; u < 2; ++u) { const int c = h * 64 + (2 * chalf + u) * 16 + fq * 4;
            prv[u] = *(const h16x4*)(zr + ZRR + c); pkv[u] = *(const h16x4*)(zr + ZRK + c); pvv[u] = *(const h16x4*)(zr + ZRV + c); }
    };
    auto prepare = [&](int nb, bool active) {
        h16x8 twf[2], alf[2]; h16x4 rv4[2], kv4[2], vv4[2];
        const int i = pw * 8 + ts; int tok = 0;
        f32x4 dwa[4], daa[4];
        if (active) {
            tok = tokof(nb * T + i);
            h16x8 w2f[4][2], a2f[4][2];
#pragma unroll
            for (int ct = 0; ct < 4; ++ct)
#pragma unroll
                for (int kb = 0; kb < 2; ++kb) { w2f[ct][kb] = *(const h16x8*)(FR + (ct * 16 + fr) * 72 + kb * 32 + fq * 8); a2f[ct][kb] = *(const h16x8*)(FR + (64 + ct * 16 + fr) * 72 + kb * 32 + fq * 8); }
#pragma unroll
            for (int kb = 0; kb < 2; ++kb) { alf[kb] = pal[kb];
                typedef unsigned u32x4_t __attribute__((ext_vector_type(4)));
                typedef unsigned u32x2_t __attribute__((ext_vector_type(2)));
                const u32x4_t raw = __builtin_bit_cast(u32x4_t, pwl[kb]);
                u32x2_t sel; sel[0] = chalf ? raw[2] : raw[0]; sel[1] = chalf ? raw[3] : raw[1];
                const h16x4 src = __builtin_bit_cast(h16x4, sel);
                h16x4 mine;
#pragma unroll
                for (int e = 0; e < 4; ++e) { const float x = (float)src[e]; const float e2 = __expf(2.f * x); mine[e] = (h16)(1.f - 2.f * __builtin_amdgcn_rcpf(e2 + 1.f)); }
                const u32x2_t mu = __builtin_bit_cast(u32x2_t, mine);
                u32x2_t ou; ou[0] = (unsigned)__builtin_amdgcn_update_dpp(0, (int)mu[0], 0x128, 0xF, 0xF, true); ou[1] = (unsigned)__builtin_amdgcn_update_dpp(0, (int)mu[1], 0x128, 0xF, 0xF, true);
                u32x4_t res; res[0] = chalf ? ou[0] : mu[0]; res[1] = chalf ? ou[1] : mu[1]; res[2] = chalf ? mu[0] : ou[0]; res[3] = chalf ? mu[1] : ou[1];
                twf[kb] = __builtin_bit_cast(h16x8, res); }
#pragma unroll
            for (int u = 0; u < 2; ++u) { rv4[u] = prv[u]; kv4[u] = pkv[u]; vv4[u] = pvv[u]; }
            if (nb + 1 < nblk) pf_load(nb + 1);
#pragma unroll
            for (int ct = 0; ct < 4; ++ct) { dwa[ct] = (f32x4){0.f, 0.f, 0.f, 0.f}; daa[ct] = dwa[ct];
#pragma unroll
                for (int kb = 0; kb < 2; ++kb) { dwa[ct] = mm32(twf[kb], w2f[ct][kb], dwa[ct]); daa[ct] = mm32(alf[kb], a2f[ct][kb], daa[ct]); } }
        }
        __syncthreads();
        if (!active) return;
        float* wbw = Wb + (nb & 1) * T * 64; h16* hbw = Hb + (nb & 1) * 5 * T * 64;
        float cw0[8], ca0[8], ckk[8], cka[8], crk[8];
#pragma unroll
        for (int u = 0; u < 2; ++u) { const int hc = h * 64 + (2 * chalf + u) * 16 + fq * 4;
            const f32x4 t0 = *(const f32x4*)(p.rw_w0 + (l * 2 + d) * 768 + hc), t1 = *(const f32x4*)(p.rw_a0 + (l * 2 + d) * 768 + hc),
                        t2 = *(const f32x4*)(p.rw_kk + l * 768 + hc), t3 = *(const f32x4*)(p.rw_ka + l * 768 + hc), t4 = *(const f32x4*)(p.rw_rk + l * 768 + hc);
#pragma unroll
            for (int jj = 0; jj < 4; ++jj) { cw0[u * 4 + jj] = t0[jj]; ca0[u * 4 + jj] = t1[jj]; ckk[u * 4 + jj] = t2[jj]; cka[u * 4 + jj] = t3[jj]; crk[u * 4 + jj] = t4[jj]; } }
        float dec[8], kd[8], kkv[8], icv[8], rr[8];
        float nrm = 0.f, bon = 0.f;
#pragma unroll
        for (int u = 0; u < 2; ++u) {
            const f32x4 dwsel = chalf ? dwa[2 + u] : dwa[u], dasel = chalf ? daa[2 + u] : daa[u];
#pragma unroll
            for (int jj = 0; jj < 4; ++jj) { const int q = u * 4 + jj;
                const float aw = cw0[q] + dwsel[jj], aa = ca0[q] + dasel[jj];
                dec[q] = __expf(-0.60653065971f * __builtin_amdgcn_rcpf(1.f + __expf(-aw)));
                icv[q] = __builtin_amdgcn_rcpf(1.f + __expf(-aa));
                const float kraw = (float)kv4[u][jj]; rr[q] = (float)rv4[u][jj];
                kkv[q] = kraw * ckk[q]; nrm += kkv[q] * kkv[q];
                kd[q] = kraw * (1.f + (icv[q] - 1.f) * cka[q]);
                bon += rr[q] * kd[q] * crk[q]; } }
        nrm += dppf<0x128>(nrm); bon += dppf<0x128>(bon);
        nrm += __shfl_xor(nrm, 16); bon += __shfl_xor(bon, 16);
        nrm += __shfl_xor(nrm, 32); bon += __shfl_xor(bon, 32);
        const float rn = rsqrtf(fmaxf(nrm, 1e-24f));
#pragma unroll
        for (int u = 0; u < 2; ++u) { const int c = (2 * chalf + u) * 16 + fq * 4; const int o = i * 64 + c;
            f32x4 wq; h16x4 kq, aq, bq, rq, vq;
#pragma unroll
            for (int jj = 0; jj < 4; ++jj) { const int q = u * 4 + jj; const float kk = kkv[q] * rn;
                wq[jj] = dec[q]; kq[jj] = (h16)kd[q]; aq[jj] = (h16)(-kk); bq[jj] = (h16)(kk * icv[q]); }
            rq = rv4[u]; vq = vv4[u];
            *(f32x4*)(wbw + o) = wq; *(h16x4*)(hbw + 0 * T * 64 + o) = kq; *(h16x4*)(hbw + 1 * T * 64 + o) = aq;
            *(h16x4*)(hbw + 2 * T * 64 + o) = bq; *(h16x4*)(hbw + 3 * T * 64 + o) = rq; *(h16x4*)(hbw + 4 * T * 64 + o) = vq; }
        if (lane == ts) bsc[(size_t)(rbase + tok) * 12 + h] = bon;
    };
    __syncthreads();
    for (int e = tid; e < 2 * 64 * 8; e += 512) { const int m = e >> 9, c = (e >> 3) & 63, j8 = (e & 7) * 8;
        *(h16x8*)(FR + (m * 64 + c) * 72 + j8) = *(const h16x8*)(p.rwT + ((size_t)((l * 2 + d) * 2 + m) * 12 + h) * 4096 + c * 64 + j8); }
    __syncthreads();
    if (!chain) { pf_load(0); prepare(0, true); } else __syncthreads();
    __syncthreads();
    for (int nb = 0; nb < nblk; ++nb) {
        if (chain) {
            { const float* bw = Wb + (nb & 1) * T * 64; const h16* hb = Hb + (nb & 1) * 5 * T * 64;
                const int gl = tid & 255, c2 = gl & 31, q = (gl >> 5) & 1, qt = gl >> 6, c = 2 * c2;
                f32x2 G[16]; { f32x2 run = (f32x2){1.f, 1.f};
#pragma unroll
                    for (int t = 0; t < 16; ++t) { run = run * *(const f32x2*)(bw + (16 * q + t) * 64 + c); G[t] = run; } }
                const f32x2 gref = G[7], gend = G[15];
                f32x2 iref; iref[0] = __builtin_amdgcn_rcpf(gref[0]); iref[1] = __builtin_amdgcn_rcpf(gref[1]);
#pragma unroll
                for (int t = 0; t < 16; ++t) {
                    if ((t >> 2) == qt) {
                        const int i = 16 * q + t; const f32x2 g = G[t], gm1 = t ? G[t - 1] : (f32x2){1.f, 1.f};
                        f32x2 ig; ig[0] = __builtin_amdgcn_rcpf(g[0]); ig[1] = __builtin_amdgcn_rcpf(g[1]);
                        const h16x2 k2 = *(const h16x2*)(hb + 0 * T * 64 + i * 64 + c), a2 = *(const h16x2*)(hb + 1 * T * 64 + i * 64 + c), b2 = *(const h16x2*)(hb + 2 * T * 64 + i * 64 + c),
                                    r2 = *(const h16x2*)(hb + 3 * T * 64 + i * 64 + c), v2 = *(const h16x2*)(hb + 4 * T * 64 + i * 64 + c);
                        const f32x2 kv_ = (f32x2){(float)k2[0], (float)k2[1]}, av = (f32x2){(float)a2[0], (float)a2[1]}, bv = (f32x2){(float)b2[0], (float)b2[1]}, rv = (f32x2){(float)r2[0], (float)r2[1]};
                        const f32x2 at = av * gm1, rt = rv * g, bs = bv * ig, ks_ = kv_ * ig;
                        const f32x2 ah_ = at * iref, rh_ = rt * iref, bh_ = bs * gref, kh_ = ks_ * gref, bb_ = bs * gend, kb_ = ks_ * gend;
                        h16x2 o;
                        o[0] = (h16)at[0]; o[1] = (h16)at[1]; *(h16x2*)(OPa + (0 * T + i) * 72 + c) = o;
                        o[0] = (h16)rt[0]; o[1] = (h16)rt[1]; *(h16x2*)(OPa + (1 * T + i) * 72 + c) = o;
                        o[0] = (h16)ah_[0]; o[1] = (h16)ah_[1]; *(h16x2*)(OPa + (2 * T + i) * 72 + c) = o;
                        o[0] = (h16)rh_[0]; o[1] = (h16)rh_[1]; *(h16x2*)(OPa + (3 * T + i) * 72 + c) = o;
                        o[0] = (h16)bh_[0]; o[1] = (h16)bh_[1]; *(h16x2*)(OPa + (4 * T + i) * 72 + c) = o;
                        o[0] = (h16)kh_[0]; o[1] = (h16)kh_[1]; *(h16x2*)(OPa + (5 * T + i) * 72 + c) = o;
                        OPt[((0 * 2 + q) * 64 + c) * 20 + t] = (h16)bb_[0]; OPt[((0 * 2 + q) * 64 + c + 1) * 20 + t] = (h16)bb_[1];
                        OPt[((1 * 2 + q) * 64 + c) * 20 + t] = (h16)kb_[0]; OPt[((1 * 2 + q) * 64 + c + 1) * 20 + t] = (h16)kb_[1];
                        OPt[((2 * 2 + q) * 64 + c) * 20 + t] = v2[0]; OPt[((2 * 2 + q) * 64 + c + 1) * 20 + t] = v2[1];
                    } }
                if (qt == 0) *(f32x2*)(Gf + q * 64 + c) = gend; }
            __syncthreads();
#pragma unroll
            for (int q = 0; q < 2; ++q) {
                const int row = 16 * q + fr;
                h16x8 ah[2], bh[2], kh[2], rh[2];
#pragma unroll
                for (int kb = 0; kb < 2; ++kb) { ah[kb] = *(const h16x8*)(OPa + (2 * T + row) * 72 + kb * 32 + fq * 8); rh[kb] = *(const h16x8*)(OPa + (3 * T + row) * 72 + kb * 32 + fq * 8);
                    bh[kb] = *(const h16x8*)(OPa + (4 * T + row) * 72 + kb * 32 + fq * 8); kh[kb] = *(const h16x8*)(OPa + (5 * T + row) * 72 + kb * 32 + fq * 8); }
                const f32x4 zero4 = (f32x4){0.f, 0.f, 0.f, 0.f};
                f32x4 NT = zero4, N = zero4, MakT = zero4, NabT = zero4, NakT = zero4;
#pragma unroll
                for (int kb = 0; kb < 2; ++kb) { NT = mm32(ah[kb], bh[kb], NT); N = mm32(bh[kb], ah[kb], N); MakT = mm32(ah[kb], kh[kb], MakT);
                    NabT = mm32(rh[kb], bh[kb], NabT); NakT = mm32(rh[kb], kh[kb], NakT); }
                f32x4 TT;
#pragma unroll
                for (int jj = 0; jj < 4; ++jj) { const int n = fq * 4 + jj, m = fr;
                    NT[jj] = (n < m) ? NT[jj] : 0.f; N[jj] = (m < n) ? N[jj] : 0.f; MakT[jj] = (n < m) ? MakT[jj] : 0.f;
                    NabT[jj] = (n <= m) ? NabT[jj] : 0.f; NakT[jj] = (n <= m) ? NakT[jj] : 0.f;
                    TT[jj] = NT[jj] + ((n == m) ? 1.f : 0.f); }
                { h16x4 pn = cvt4(N), pt = cvt4(NT);
                    f32x4 N2 = mm16(pn, pt, zero4), N2T = mm16(pt, pn, zero4);
                    TT = mm16(cvt4(TT), cvt4(N2), TT);
                    pn = cvt4(N2); pt = cvt4(N2T);
                    f32x4 N4 = mm16(pn, pt, zero4), N4T = mm16(pt, pn, zero4);
                    TT = mm16(cvt4(TT), cvt4(N4), TT);
                    const f32x4 N8 = mm16(cvt4(N4), cvt4(N4T), zero4);
                    TT = mm16(cvt4(TT), cvt4(N8), TT); }
                h16x8 sf[2];
#pragma unroll
                for (int kb = 0; kb < 2; ++kb)
#pragma unroll
                    for (int e = 0; e < 4; ++e) { sf[kb][e] = (h16)S[2 * kb][e]; sf[kb][4 + e] = (h16)S[2 * kb + 1][e]; }
                h16x8 atp[2], rtp[2];
#pragma unroll
                for (int kb = 0; kb < 2; ++kb) { const h16x4 a0 = *(const h16x4*)(OPa + (0 * T + row) * 72 + (2 * kb) * 16 + fq * 4), a1 = *(const h16x4*)(OPa + (0 * T + row) * 72 + (2 * kb + 1) * 16 + fq * 4);
                    const h16x4 r0 = *(const h16x4*)(OPa + (1 * T + row) * 72 + (2 * kb) * 16 + fq * 4), r1 = *(const h16x4*)(OPa + (1 * T + row) * 72 + (2 * kb + 1) * 16 + fq * 4);
#pragma unroll
                    for (int e = 0; e < 4; ++e) { atp[kb][e] = a0[e]; atp[kb][4 + e] = a1[e]; rtp[kb][e] = r0[e]; rtp[kb][4 + e] = r1[e]; } }
                const h16x4 vt4 = *(const h16x4*)(OPt + ((2 * 2 + q) * 64 + v0 + fr) * 20 + fq * 4);
                f32x4 X = zero4, Y = zero4;
#pragma unroll
                for (int kb = 0; kb < 2; ++kb) { X = mm32(sf[kb], atp[kb], X); Y = mm32(sf[kb], rtp[kb], Y); }
                X = mm16(vt4, cvt4(MakT), X);
                const f32x4 SA = mm16(cvt4(X), cvt4(TT), zero4);
                const h16x4 sa4 = cvt4(SA);
                Y = mm16(sa4, cvt4(NabT), Y);
                Y = mm16(vt4, cvt4(NakT), Y);
#pragma unroll
                for (int kt = 0; kt < 4; ++kt) { const f32x4 g = *(const f32x4*)(Gf + q * 64 + kt * 16 + fq * 4);
                    const h16x4 bb = *(const h16x4*)(OPt + ((0 * 2 + q) * 64 + kt * 16 + fr) * 20 + fq * 4), kb4 = *(const h16x4*)(OPt + ((1 * 2 + q) * 64 + kt * 16 + fr) * 20 + fq * 4);
                    f32x4 acc = S[kt] * g; acc = mm16(sa4, bb, acc); S[kt] = mm16(vt4, kb4, acc); }
#pragma unroll
                for (int jj = 0; jj < 4; ++jj) { const int tok = tokof(nb * T + 16 * q + fq * 4 + jj);
                    ybuf[(size_t)(rbase + tok) * 768 + h * 64 + v0 + fr] = (h16)Y[jj]; }
            }
        } else {
            prepare(nb + 1, nb + 1 < nblk);
        }
        __syncthreads();
    }
    if (chain && !lat) { float* so = p.out + OUT_SR + ((((size_t)b * 2 + l) * 2 + d) * 12 + h) * 4096;
#pragma unroll
        for (int kt = 0; kt < 4; ++kt) __builtin_nontemporal_store(S[kt], (f32x4*)(so + (v0 + fr) * 64 + kt * 16 + fq * 4)); }
    __syncthreads();
}

constexpr int NI_RWL = 96, NI_GLL = 48, NI_RWC = 768, NI_GLC = 384, NI_CM = 512, NI_TOTAL = NI_RWL + NI_GLL + NI_RWC + NI_GLC + NI_CM;

__device__ void phase_mixers(const Params& p, int l, unsigned char* lds, int cidx) {
    volatile int& s_item = *(volatile int*)(lds + 147440);
    for (;;) {
        if (threadIdx.x == 0) s_item = (int)atomicAdd(p.ctr + cidx, 1u);
        __syncthreads();
        int it = s_item;
        if (it >= NI_TOTAL) break;
        { const int ty = it < NI_RWL ? 1 : it < NI_RWL + NI_GLL ? 2 : it < NI_RWL + NI_GLL + NI_RWC ? 4 : it < NI_RWL + NI_GLL + NI_RWC + NI_GLC ? 8 : 16; if (!(p.sub & ty)) { __syncthreads(); continue; } }
#ifndef NO_RWKV
        if (it < NI_RWL) { rwkv_unit(p, l, true, it / 24, (it % 24) >> 1, it & 1, lds); continue; }
#endif
        it -= NI_RWL;
#ifndef NO_GLA
        if (it < NI_GLL) { gla_unit(p, l, true, it / 12, (it % 12) >> 1, it & 1, lds); continue; }
#endif
        it -= NI_GLL;
#ifndef NO_RWKV
        if (it < NI_RWC) { rwkv_unit(p, l, false, it / 24, (it % 24) >> 1, it & 1, lds); continue; }
#endif
        it -= NI_RWC;
#ifndef NO_GLA
        if (it < NI_GLC) { gla_unit(p, l, false, it / 12, (it % 12) >> 1, it & 1, lds); continue; }
#endif
        it -= NI_GLC;
#ifndef NO_CM
        cm_unit(p, l, (it >> 2) * 128, it & 3, lds);
#endif
    }
}

constexpr int NPHASE = 12;
template <int L> __device__ __forceinline__ void run_gemm1(const Params& p, unsigned char* lds) {
    pg8::Gemm g{p.hbuf, p.wT_in, NTOK, INWP, D}; pg8::StaticOrder S; S.init(NTOK, INWP, gridDim.x, blockIdx.x); pg8::EpiZ E{p.z};
    pg8::gemm_phase((LAS unsigned char*)lds, g, S, E);
}
template <int L> __device__ __forceinline__ void run_gemm2(const Params& p, unsigned char* lds) {
    pg8::Gemm g{p.hbuf, p.wT_out + (size_t)L * D * D, NTOK, D, D}; pg8::StaticOrder S; S.init(NTOK, D, gridDim.x, blockIdx.x);
    h16* slotA = (h16*)p.out; h16* slotB = (h16*)p.out + (size_t)NTOK * D;
    pg8::EpiRes E{L == 0 ? slotA : slotB, L == 0 ? slotB : p.gla_of, p.mod + (size_t)L * 5 * 6144 + 4096};
    pg8::gemm_phase((LAS unsigned char*)lds, g, S, E);
}
#define RUN_PHASE(K, BODY) if (p.ph_lo <= (K) && (K) < p.ph_hi) { BODY; if ((K) + 1 < p.ph_hi) xcd_barrier(xb); }
__global__ void __launch_bounds__(512, 2) mega(Params p) {
    extern __shared__ __attribute__((aligned(16))) unsigned char lds[];
    cg::grid_group grid = cg::this_grid();
    uint4& xb_words = *(uint4*)(lds + 147424);
    if (threadIdx.x == 0) xb_words = make_uint4(0u, 0u, 0u, 0u);
    __syncthreads();
    XcdBarrier xb; xb.bar = p.bar; xb.x = 0; xb.st = (volatile LAS unsigned*)&xb_words;
    if (p.ph_hi - p.ph_lo > 1) xb = xcd_barrier_post(p.bar, (volatile LAS unsigned*)&xb_words);
    if (p.ph_lo > 1000) grid.sync();
    RUN_PHASE(0, phase_prologue(p, (float*)lds))
    RUN_PHASE(1, phase_prep(p, 0))
    RUN_PHASE(2, run_gemm1<0>(p, lds))
    RUN_PHASE(3, phase_mixers(p, 0, lds, 0))
    RUN_PHASE(4, phase_combine(p, 0); conv_win(p, 1, (float*)lds, blockIdx.x, gridDim.x))
    RUN_PHASE(5, run_gemm2<0>(p, lds))
    RUN_PHASE(6, phase_prep(p, 1))
    RUN_PHASE(7, run_gemm1<1>(p, lds))
    RUN_PHASE(8, phase_mixers(p, 1, lds, 1))
    RUN_PHASE(9, phase_combine(p, 1))
    RUN_PHASE(10, run_gemm2<1>(p, lds))
    RUN_PHASE(11, phase_final(p))
#ifdef PROBE_SYNC
    for (int i = 0; i < PROBE_SYNC; ++i) grid.sync();
#endif
}

extern "C" void kernel_launch(void* const* d_in, const int* in_sizes, int n_in, void* d_out, int out_size, void* d_ws, size_t ws_size, hipStream_t stream) {
    static int grid_blocks = 0;
    if (!grid_blocks) {
        int dev = 0, cus = 0, per_cu = 0;
        hipGetDevice(&dev);
        hipDeviceGetAttribute(&cus, hipDeviceAttributeMultiprocessorCount, dev);
        hipFuncSetAttribute((const void*)mega, hipFuncAttributeMaxDynamicSharedMemorySize, LDS_BYTES);
        hipOccupancyMaxActiveBlocksPerMultiprocessor(&per_cu, (const void*)mega, 512, LDS_BYTES);
        if (per_cu < 1) per_cu = 1;
        grid_blocks = cus * per_cu;
    }
    Params p{};
    const float** pin = (const float**)&p;
    for (int i = 0; i < 26; ++i) pin[i] = (const float*)d_in[i];
    p.out = (float*)d_out;
    unsigned char* ws = (unsigned char*)d_ws;
    size_t off = 0;
    auto take = [&](size_t bytes) { unsigned char* r = ws + off; off += (bytes + 255) & ~(size_t)255; return r; };
    p.bar = (unsigned*)take(XCD_BAR_WORDS * 4);
    p.ctr = (unsigned*)take(256);
    p.mod = (float*)take(2 * 5 * 6144 * 4);
    p.bscal = (float*)take((size_t)2 * NTOK * 12 * 4);
    p.rwT = (h16*)take((size_t)2 * 2 * 2 * 12 * 64 * 64 * 2);
    p.wT_in = (h16*)take((size_t)INWP * D * 2);
    p.wT_out = (h16*)take((size_t)2 * D * D * 2);
    p.hbuf = (h16*)take((size_t)NTOK * D * 2);
    p.z = (h16*)take((size_t)NTOK * INW * 2);
    p.gla_of = (h16*)take((size_t)NTOK * 768 * 2);
    p.gla_ob = (h16*)take((size_t)NTOK * 768 * 2);
    p.rw_yf = (h16*)take((size_t)NTOK * 768 * 2);
    p.rw_yb = (h16*)take((size_t)NTOK * 768 * 2);
    if (off > ws_size) { fprintf(stderr, "workspace too small: need %zu have %zu\n", off, ws_size); return; }
    hipMemsetAsync(p.bar, 0, ((XCD_BAR_WORDS * 4 + 255) & ~255) + 256, stream);
#if MULTI_LAUNCH
    for (int ph = 0; ph < NPHASE; ++ph) { p.ph_lo = ph; p.ph_hi = ph + 1;
        const int reps = ((PROBE_REP >> ph) & 1) ? 2 : 1;
        for (int r = 0; r < reps; ++r) { if (r) hipMemsetAsync(p.ctr, 0, 256, stream); p.sub = r ? PROBE_SUB : 31;
            hipLaunchKernelGGL(mega, dim3(grid_blocks), dim3(512), LDS_BYTES, stream, p); } }
#else
    p.ph_lo = 0; p.ph_hi = NPHASE; p.sub = 31;
    void* args[] = {&p};
    hipError_t e = hipLaunchCooperativeKernel((const void*)mega, dim3(grid_blocks), dim3(512), args, LDS_BYTES, stream);
    if (e != hipSuccess) fprintf(stderr, "cooperative launch failed: %s (grid %d)\n", hipGetErrorString(e), grid_blocks);
#endif
}
```
